# Optimizing an MI355X kernel written in HIP

```python
import math
import jax, jax.numpy as jnp
from jax import lax
import numpy as np

D_MODEL = 1024
BATCH = 8
SEQ = 4096
DEPTH = 1

N_MEM = 256
RMS_EPS = 1e-6
NEG_INF = -1e30

HG_EXPAND = 128
HG_HEADS = D_MODEL // HG_EXPAND
HG_DK = HG_EXPAND
HG_DV = D_MODEL // HG_HEADS
HG_WIDTH = HG_HEADS * HG_DV
HG_CHUNK = 64
HG_SCALE = HG_DK ** -0.5

DA_CONFIGS = ((128, 1), (512, 4), (2048, 16))
DA_HEADS_PER_GROUP = 4
DA_HEADS = DA_HEADS_PER_GROUP * len(DA_CONFIGS)
DA_HEAD_DIM = D_MODEL // 8
DA_QKV_WIDTH = DA_HEADS * DA_HEAD_DIM
DA_WIDTH = DA_HEADS_PER_GROUP * DA_HEAD_DIM
DA_SCALE = DA_HEAD_DIM ** -0.5

MEM_HEADS = 4
MEM_HEAD_DIM = D_MODEL // 8
MEM_WIDTH = MEM_HEADS * MEM_HEAD_DIM
MEM_SCALE = MEM_HEAD_DIM ** -0.5

D_FF = ((8 * D_MODEL // 3 + 255) // 256) * 256

IN_SPLITS = (HG_WIDTH,) * 5 + (DA_QKV_WIDTH,) * 3 + (MEM_WIDTH,) + (D_MODEL,) * 3
IN_COLS = sum(IN_SPLITS)
IN_SPLIT_POINTS = tuple(int(p) for p in np.cumsum(IN_SPLITS)[:-1])

kernel_name = "hybrid_hgrn2_dilated_memory_block"


def rmsnorm(x, gain):
    xf = x.astype(jnp.float32)
    y = xf * lax.rsqrt(jnp.mean(xf * xf, axis=-1, keepdims=True) + RMS_EPS)
    return (y * gain.astype(jnp.float32)).astype(x.dtype)


def alibi_slopes(n):
    return (2.0 ** (-8.0 * np.arange(1, n + 1) / n)).astype(np.float32)


def gla_chunkwise(q, k, v, log_f):
    B, H, L, dk = q.shape
    dv = v.shape[-1]
    C = HG_CHUNK
    n = L // C
    q, k, log_f = [t.reshape(B, H, n, C, dk) for t in (q, k, log_f)]
    v = v.reshape(B, H, n, C, dv)
    b = jnp.cumsum(log_f.astype(jnp.float32), axis=3)
    b_last = b[:, :, :, -1:, :]
    q_in = q * jnp.exp(b)
    k_in = k * jnp.exp(-b)
    k_st = k * jnp.exp(b_last - b)
    causal = jnp.tril(jnp.ones((C, C), dtype=bool))
    a = jnp.where(causal, jnp.einsum('bhnti,bhnsi->bhnts', q_in, k_in), 0.0)
    o_intra = jnp.einsum('bhnts,bhnsj->bhntj', a, v)
    chunk_state = jnp.einsum('bhnsi,bhnsj->bhnij', k_st, v)
    decay = jnp.exp(b_last[:, :, :, 0, :])

    def step(S, inp):
        d, s = inp
        return d[..., None] * S + s, S

    S0 = jnp.zeros((B, H, dk, dv), jnp.float32)
    _, S_in = lax.scan(step, S0, (jnp.moveaxis(decay, 2, 0), jnp.moveaxis(chunk_state, 2, 0)))
    S_in = jnp.moveaxis(S_in, 0, 2)
    o_inter = jnp.einsum('bhnti,bhnij->bhntj', q_in, S_in)
    return (o_intra + o_inter).reshape(B, H, L, dv)


def hgrn2_mixer(q, f_fw, f_bw, inp, gate, lb_fw, lb_bw, norm_gain):
    B, L, _ = q.shape

    def to_heads(t):
        return t.reshape(B, L, HG_HEADS, -1).transpose(0, 2, 1, 3)

    qh = to_heads(jax.nn.silu(q)) * HG_SCALE
    vh = to_heads(inp)

    def direction(f_logit, lb, flip):
        forget = lb + (1.0 - lb) * jax.nn.sigmoid(f_logit.astype(jnp.float32))
        kh, logf = to_heads(1.0 - forget), to_heads(jnp.log(forget))
        if flip:
            rev = lambda t: jnp.flip(t, axis=2)
            return rev(gla_chunkwise(rev(qh), rev(kh), rev(vh), rev(logf)))
        return gla_chunkwise(qh, kh, vh, logf)

    o = direction(f_fw, lb_fw, False) + direction(f_bw, lb_bw, True)
    o = o.transpose(0, 2, 1, 3)
    o = rmsnorm(o, norm_gain) * jax.nn.silu(gate.reshape(B, L, HG_HEADS, HG_DV).astype(jnp.float32))
    return o.reshape(B, L, HG_WIDTH).astype(q.dtype)


def dilated_group(q, k, v, dilation, radius, slopes):
    B, L, Hg, dh = q.shape
    d, P = dilation, radius
    Ld = L // d
    nb = -(-Ld // P)
    Lp = nb * P

    def residues(t):
        return t.reshape(B, Ld, d, Hg, dh).transpose(0, 3, 2, 1, 4)

    qr, kr, vr = residues(q), residues(k), residues(v)
    qb = jnp.pad(qr, ((0, 0),) * 3 + ((0, Lp - Ld), (0, 0))).reshape(B, Hg, d, nb, P, dh)
    kv_pad = ((0, 0),) * 3 + ((P, Lp - Ld + P), (0, 0))

    def key_blocks(t):
        tb = jnp.pad(t, kv_pad).reshape(B, Hg, d, nb + 2, P, dh)
        return jnp.concatenate([tb[:, :, :, :-2], tb[:, :, :, 1:-1], tb[:, :, :, 2:]], axis=4)

    kb, vb = key_blocks(kr), key_blocks(vr)
    qi = jnp.arange(P)[:, None]
    kj = jnp.arange(3 * P)[None, :]
    rel = kj - P - qi
    s_pos = jnp.arange(nb)[:, None, None] * P + kj[None] - P
    valid = (jnp.abs(rel) <= radius)[None] & (s_pos >= 0) & (s_pos < Ld)
    dist = (d * jnp.abs(rel)).astype(jnp.float32)
    slopes = jnp.asarray(slopes, jnp.float32)

    scores = jnp.einsum('bhrnid,bhrnjd->bhrnij', qb, kb).astype(jnp.float32) * DA_SCALE
    scores = scores - slopes[:, None, None, None, None] * dist
    scores = jnp.where(valid, scores, NEG_INF)
    lse = jax.nn.logsumexp(scores, axis=-1)
    p = jnp.exp(scores - lse[..., None])
    o = jnp.einsum('bhrnij,bhrnjd->bhrnid', p.astype(vb.dtype), vb)
    o = o.reshape(B, Hg, d, Lp, dh)[:, :, :, :Ld]
    o = o.transpose(0, 3, 2, 1, 4).reshape(B, L, Hg, dh)
    lse = lse.reshape(B, Hg, d, Lp)[:, :, :, :Ld].transpose(0, 3, 2, 1).reshape(B, L, Hg)
    return o, lse


def dilated_mixer(q, k, v, q_gain, k_gain):
    B, L, _ = q.shape
    q = rmsnorm(q.reshape(B, L, DA_HEADS, DA_HEAD_DIM), q_gain)
    k = rmsnorm(k.reshape(B, L, DA_HEADS, DA_HEAD_DIM), k_gain)
    v = v.reshape(B, L, DA_HEADS, DA_HEAD_DIM)
    slopes = alibi_slopes(DA_HEADS)
    outs, lses = [], []
    for g, (window, dilation) in enumerate(DA_CONFIGS):
        lo, hi = g * DA_HEADS_PER_GROUP, (g + 1) * DA_HEADS_PER_GROUP
        o, lse = dilated_group(q[:, :, lo:hi], k[:, :, lo:hi], v[:, :, lo:hi],
                               dilation, window // (2 * dilation), slopes[lo:hi])
        outs.append(o)
        lses.append(lse)
    w = jax.nn.softmax(jnp.stack(lses, axis=0), axis=0)
    o = jnp.sum(w[..., None] * jnp.stack(outs, axis=0).astype(jnp.float32), axis=0)
    return o.reshape(B, L, DA_WIDTH).astype(q.dtype)


def memory_mixer(q, mem_n, w_kv, q_gain, k_gain):
    B, L, _ = q.shape
    M = mem_n.shape[1]
    k, v = jnp.split(mem_n @ w_kv, 2, axis=-1)
    qh = rmsnorm(q.reshape(B, L, MEM_HEADS, MEM_HEAD_DIM), q_gain)
    kh = rmsnorm(k.reshape(B, M, MEM_HEADS, MEM_HEAD_DIM), k_gain)
    vh = v.reshape(B, M, MEM_HEADS, MEM_HEAD_DIM)
    s = jnp.einsum('blhd,bmhd->bhlm', qh, kh).astype(jnp.float32) * MEM_SCALE
    p = jax.nn.softmax(s, axis=-1)
    o = jnp.einsum('bhlm,bmhd->blhd', p.astype(vh.dtype), vh)
    return o.reshape(B, L, MEM_WIDTH)


def setup_inputs(seed: int = 0) -> dict:
    key = jax.random.key(seed)
    ks = jax.random.split(key, 22)

    def w(k, shape, fan_in):
        return jax.random.normal(k, shape, jnp.float32) * fan_in ** -0.5

    def gain(k, shape):
        return 1.0 + 0.02 * jax.random.normal(k, shape, jnp.float32)

    return {
        "x": jax.random.normal(ks[0], (BATCH, SEQ, D_MODEL), jnp.float32),
        "mem": jax.random.normal(ks[1], (BATCH, N_MEM, D_MODEL), jnp.float32),
        "norm_mix_gain": gain(ks[2], (DEPTH, D_MODEL)),
        "norm_mem_gain": gain(ks[3], (DEPTH, D_MODEL)),
        "w_in": w(ks[4], (DEPTH, D_MODEL, IN_COLS), D_MODEL),
        "lb_logits_fw": 0.1 * jax.random.normal(ks[5], (DEPTH + 1, HG_WIDTH), jnp.float32),
        "lb_logits_bw": 0.1 * jax.random.normal(ks[6], (DEPTH + 1, HG_WIDTH), jnp.float32),
        "hg_norm_gain": gain(ks[7], (DEPTH, HG_DV)),
        "da_q_gain": gain(ks[8], (DEPTH, DA_HEAD_DIM)),
        "da_k_gain": gain(ks[9], (DEPTH, DA_HEAD_DIM)),
        "w_mem_kv": w(ks[10], (DEPTH, D_MODEL, 2 * MEM_WIDTH), D_MODEL),
        "mem_q_gain": gain(ks[11], (DEPTH, MEM_HEAD_DIM)),
        "mem_k_gain": gain(ks[12], (DEPTH, MEM_HEAD_DIM)),
        "w_proj_hg": w(ks[13], (DEPTH, HG_WIDTH, D_MODEL), HG_WIDTH),
        "w_proj_da": w(ks[14], (DEPTH, DA_WIDTH, D_MODEL), DA_WIDTH),
        "w_proj_mem": w(ks[15], (DEPTH, MEM_WIDTH, D_MODEL), MEM_WIDTH),
        "w_out": w(ks[16], (DEPTH, D_MODEL, D_MODEL), D_MODEL),
        "norm_ffn_gain": gain(ks[17], (DEPTH, D_MODEL)),
        "w_ffn_in": w(ks[18], (DEPTH, D_MODEL, 2 * D_FF), D_MODEL),
        "w_ffn_out": w(ks[19], (DEPTH, D_FF, D_MODEL), D_FF),
    }


def reference(x, mem, norm_mix_gain, norm_mem_gain, w_in, lb_logits_fw, lb_logits_bw,
              hg_norm_gain, da_q_gain, da_k_gain, w_mem_kv, mem_q_gain, mem_k_gain,
              w_proj_hg, w_proj_da, w_proj_mem, w_out, norm_ffn_gain, w_ffn_in, w_ffn_out):
    lb_fw_table = jnp.cumsum(jax.nn.softmax(lb_logits_fw.astype(jnp.float32), axis=0), axis=0)
    lb_bw_table = jnp.cumsum(jax.nn.softmax(lb_logits_bw.astype(jnp.float32), axis=0), axis=0)
    for l in range(DEPTH):
        h = rmsnorm(x, norm_mix_gain[l])
        proj = h @ w_in[l]
        (hg_q, hg_f_fw, hg_f_bw, hg_i, hg_g, da_q, da_k, da_v, mem_q,
         gate_hg, gate_da, gate_mem) = jnp.split(proj, IN_SPLIT_POINTS, axis=-1)

        o_hg = hgrn2_mixer(hg_q, hg_f_fw, hg_f_bw, hg_i, hg_g,
                           lb_fw_table[l], lb_bw_table[l], hg_norm_gain[l])
        o_da = dilated_mixer(da_q, da_k, da_v, da_q_gain[l], da_k_gain[l])
        mem_n = rmsnorm(mem, norm_mem_gain[l])
        o_mem = memory_mixer(mem_q, mem_n, w_mem_kv[l], mem_q_gain[l], mem_k_gain[l])

        merged = (jax.nn.sigmoid(gate_hg) * (o_hg @ w_proj_hg[l])
                  + jax.nn.sigmoid(gate_da) * (o_da @ w_proj_da[l])
                  + jax.nn.sigmoid(gate_mem) * (o_mem @ w_proj_mem[l]))
        x = x + merged @ w_out[l]

        h = rmsnorm(x, norm_ffn_gain[l])
        a, b = jnp.split(h @ w_ffn_in[l], 2, axis=-1)
        x = x + (jax.nn.silu(a) * b) @ w_ffn_out[l]
    return x
```

```cpp
#include <hip/hip_runtime.h>
#include <cstdio>
#include <cstdint>
#include <cmath>
namespace pg8 {
#define PG8_LAS __attribute__((address_space(3)))
typedef unsigned short bf16_t;
typedef short bf16x8 __attribute__((ext_vector_type(8)));
typedef float f32x4 __attribute__((ext_vector_type(4)));
typedef unsigned u32x4 __attribute__((ext_vector_type(4)));
constexpr int BM = 256, BK = 64, HALF = 128, HTB = HALF * BK * 2  , STAGE_BYTES = 8 * HTB, NXCD = 8, WGM = 8;

__host__ __device__ __forceinline__ int lds_byte(int r, int c) { const int st = (r >> 4) * 2 + (c >> 5), rr = r & 15, cc = c & 31, ob = rr * 64 + cc * 2; return st * 1024 + (ob ^ (((ob >> 9) & 1) << 5)); }
__host__ __device__ __forceinline__ void stage_rc(int b, int& R, int& C) { const int st = b / 1024, sb = b % 1024, swz = sb ^ (((sb >> 9) & 1) << 5); R = (st >> 1) * 16 + swz / 64; C = (st & 1) * 32 + (swz % 64) / 2; }
__host__ __device__ __forceinline__ int perm32(int rho) { const int n = rho >> 4, i = rho & 15; return 8 * (i >> 2) + 4 * n + (i & 3); }

struct Unit { int pm, pn; };
struct Gemm { const bf16_t* A; const bf16_t* Bt; int M, N, K; };

struct StaticOrder {
    int nM, nN, nwg, G, c;
    __host__ __device__ void init(int M, int N, int G_, int c_) { nM = M / BM; nN = N / BM; nwg = nM * nN; G = G_; c = c_; }
    __host__ __device__ bool next(int i, Unit& u) const {
        const long L = (long)i * G + c; if (L >= nwg) return false;
        int wgid = (int)L; { const int q = nwg / NXCD, r = nwg % NXCD, xcd = wgid % NXCD, off = wgid / NXCD; wgid = (xcd < r ? xcd * (q + 1) : r * (q + 1) + (xcd - r) * q) + off; }
        const int nig = WGM * nN, gid = wgid / nig, fm = gid * WGM, gsz = (nM - fm) < WGM ? (nM - fm) : WGM;
        u.pm = fm + ((wgid % nig) % gsz); u.pn = (wgid % nig) / gsz; return true;
    }
    __device__ __forceinline__ void a_ready(const Unit&) const {}
    __device__ __forceinline__ void done(const Unit&) const {}
};

__device__ __forceinline__ unsigned cvt_pk_bf16(float lo, float hi) { unsigned r; asm volatile("v_cvt_pk_bf16_f32 %0, %1, %2" : "=v"(r) : "v"(lo), "v"(hi)); return r; }

typedef float f32x2 __attribute__((ext_vector_type(2)));
typedef unsigned u32x2 __attribute__((ext_vector_type(2)));
__device__ __forceinline__ float bf_lo(unsigned w) { return __builtin_bit_cast(float, w << 16); }
__device__ __forceinline__ float bf_hi(unsigned w) { return __builtin_bit_cast(float, w & 0xffff0000u); }
__device__ __forceinline__ float sigmoid_f(float v) { return __builtin_amdgcn_rcpf(1.0f + __expf(-v)); }
__device__ __forceinline__ unsigned pk_f16(float lo, float hi) { const _Float16 a = (_Float16)lo, b = (_Float16)hi; return (unsigned)__builtin_bit_cast(unsigned short, a) | ((unsigned)__builtin_bit_cast(unsigned short, b) << 16); }

template <int MODE> __device__ __forceinline__ u32x4 pack8(f32x4 v0, f32x4 v1, f32x4 l0, f32x4 l1) {
    u32x4 w;
    if (MODE == 0) { w.x = cvt_pk_bf16(v0[0], v0[1]); w.y = cvt_pk_bf16(v0[2], v0[3]); w.z = cvt_pk_bf16(v1[0], v1[1]); w.w = cvt_pk_bf16(v1[2], v1[3]); }
    else if (MODE == 2) {
        float r[8];
#pragma unroll
        for (int e = 0; e < 4; ++e) { const float s0 = sigmoid_f(v0[e]), s1 = sigmoid_f(v1[e]); r[e] = __logf(l0[e] + (1.0f - l0[e]) * s0); r[4 + e] = __logf(l1[e] + (1.0f - l1[e]) * s1); }
        w.x = pk_f16(r[0], r[1]); w.y = pk_f16(r[2], r[3]); w.z = pk_f16(r[4], r[5]); w.w = pk_f16(r[6], r[7]);
    } else {
        float r[8];
#pragma unroll
        for (int e = 0; e < 4; ++e) {
            const float s0 = sigmoid_f(v0[e]), s1 = sigmoid_f(v1[e]);
            if (MODE == 1) { r[e] = v0[e] * s0 * 0.08838834764831845f; r[4 + e] = v1[e] * s1 * 0.08838834764831845f; }
            else if (MODE == 3) { r[e] = v0[e] * s0; r[4 + e] = v1[e] * s1; }
            else { r[e] = fmaxf(s0, 1e-20f); r[4 + e] = fmaxf(s1, 1e-20f); }
        }
        w.x = cvt_pk_bf16(r[0], r[1]); w.y = cvt_pk_bf16(r[2], r[3]); w.z = cvt_pk_bf16(r[4], r[5]); w.w = cvt_pk_bf16(r[6], r[7]);
    }
    return w;
}
template <int MODE> __device__ __forceinline__ void store_tile(const f32x4 (&acc)[2][2][4][2], bf16_t* base, int ldc, int row0, int col0, const float* lb) {
    f32x4 l[2][2];
#pragma unroll
    for (int bj = 0; bj < 2; ++bj)
#pragma unroll
        for (int n = 0; n < 2; ++n) l[bj][n] = (MODE == 2) ? *(const f32x4*)(lb + col0 + bj * HALF + 4 * n) : (f32x4){0.f, 0.f, 0.f, 0.f};
#pragma unroll
    for (int ai = 0; ai < 2; ++ai)
#pragma unroll
        for (int m = 0; m < 4; ++m) { bf16_t* rowp = base + (size_t)(row0 + ai * HALF + m * 16) * ldc + col0;
#pragma unroll
            for (int bj = 0; bj < 2; ++bj) *(u32x4*)(rowp + bj * HALF) = pack8<MODE>(acc[ai][bj][m][0], acc[ai][bj][m][1], l[bj][0], l[bj][1]);
            asm volatile("" ::: "memory"); }
}

struct EpiProj {
    static constexpr bool PERM = true, AFTER_DRAIN = false, HAS_MID = false; static constexpr int MID0 = -1, MID1 = -1;
    unsigned char* ws; bf16_t* gates; const float* lb;
    static constexpr size_t O_HGQ = 116ull << 20, O_LFF = 148ull << 20, O_LFB = 180ull << 20, O_HGV = 212ull << 20, O_HGG = 244ull << 20, O_DAQ = 276ull << 20, O_DAK = 324ull << 20, O_DAV = 372ull << 20, O_MQ = 420ull << 20;
    __device__ __forceinline__ void operator()(const f32x4 (&acc)[2][2][4][2], const Unit& u, int wr, int wc, int fr, int fq) const {
        const int pn = u.pn, row0 = u.pm * BM + wr * 64 + fr, cl = wc * 32 + 8 * fq;
        if (pn < 4)       store_tile<1>(acc, (bf16_t*)(ws + O_HGQ), 1024, row0, pn * 256 + cl, nullptr);
        else if (pn < 12) store_tile<2>(acc, (bf16_t*)(ws + (pn < 8 ? O_LFF : O_LFB)), 1024, row0, ((pn - 4) & 3) * 256 + cl, lb + (pn < 8 ? 0 : 1024));
        else if (pn < 20) { if (pn < 16) store_tile<0>(acc, (bf16_t*)(ws + O_HGV), 1024, row0, (pn - 12) * 256 + cl, nullptr); else store_tile<3>(acc, (bf16_t*)(ws + O_HGG), 1024, row0, (pn - 16) * 256 + cl, nullptr); }
        else if (pn < 38) { const int s = (pn - 20) / 6, c0 = (pn - 20) - 6 * s;
            store_tile<0>(acc, (bf16_t*)(ws + O_DAQ + (size_t)s * (48ull << 20)), 1536, row0, c0 * 256 + cl, nullptr); }
        else if (pn < 40) store_tile<0>(acc, (bf16_t*)(ws + O_MQ), 512, row0, (pn - 38) * 256 + cl, nullptr);
        else              store_tile<4>(acc, gates, 3072, row0, (pn - 40) * 256 + cl, nullptr);
    }
};
struct EpiRaw {
    static constexpr bool PERM = true, AFTER_DRAIN = false, HAS_MID = false; static constexpr int MID0 = -1, MID1 = -1;
    bf16_t* O; int ldc;
    __device__ __forceinline__ void operator()(const f32x4 (&acc)[2][2][4][2], const Unit& u, int wr, int wc, int fr, int fq) const {
        store_tile<0>(acc, O, ldc, u.pm * BM + wr * 64 + fr, u.pn * 256 + wc * 32 + 8 * fq, nullptr);
    }
};
struct EpiMerged {
    static constexpr bool PERM = true, AFTER_DRAIN = false, HAS_MID = true; static constexpr int MID0 = 16, MID1 = 24;
    const bf16_t* gates; bf16_t* O; int row_off;
    __device__ __forceinline__ void mid(f32x4 (&acc)[2][2][4][2], const Unit& u, int t, int wr, int wc, int fr, int fq) const {
        int row0 = u.pm * BM + wr * 64 + fr, col0 = u.pn * BM + wc * 32 + 8 * fq + (t == MID0 ? 0 : 1024);
        asm volatile("" : "+v"(row0), "+v"(col0));
#pragma unroll
        for (int ai = 0; ai < 2; ++ai)
#pragma unroll
            for (int m = 0; m < 4; ++m) { const bf16_t* gp = gates + ((unsigned)(row0 + ai * HALF + m * 16) * 3072u + (unsigned)col0);
#pragma unroll
                for (int bj = 0; bj < 2; ++bj) { const u32x4 a = *(const u32x4*)(gp + bj * HALF), b = *(const u32x4*)(gp + bj * HALF + 1024);
                    f32x4 r0, r1;
                    r0[0] = bf_lo(a.x) * __builtin_amdgcn_rcpf(bf_lo(b.x)); r0[1] = bf_hi(a.x) * __builtin_amdgcn_rcpf(bf_hi(b.x));
                    r0[2] = bf_lo(a.y) * __builtin_amdgcn_rcpf(bf_lo(b.y)); r0[3] = bf_hi(a.y) * __builtin_amdgcn_rcpf(bf_hi(b.y));
                    r1[0] = bf_lo(a.z) * __builtin_amdgcn_rcpf(bf_lo(b.z)); r1[1] = bf_hi(a.z) * __builtin_amdgcn_rcpf(bf_hi(b.z));
                    r1[2] = bf_lo(a.w) * __builtin_amdgcn_rcpf(bf_lo(b.w)); r1[3] = bf_hi(a.w) * __builtin_amdgcn_rcpf(bf_hi(b.w));
                    acc[ai][bj][m][0] *= r0; acc[ai][bj][m][1] *= r1; }
                if (m == 3) asm volatile("" ::: "memory"); }
    }
    __device__ __forceinline__ void operator()(const f32x4 (&acc)[2][2][4][2], const Unit& u, int wr, int wc, int fr, int fq) const {
        const int row0 = u.pm * BM + wr * 64 + fr, col0 = u.pn * BM + wc * 32 + 8 * fq;
#pragma unroll
        for (int ai = 0; ai < 2; ++ai)
#pragma unroll
            for (int m = 0; m < 4; ++m) { const int r = row0 + ai * HALF + m * 16; const bf16_t* gp = gates + (size_t)r * 3072 + 2048 + col0; bf16_t* op = O + (size_t)(row_off + r) * 1024 + col0;
#pragma unroll
                for (int bj = 0; bj < 2; ++bj) { const u32x4 g = *(const u32x4*)(gp + bj * HALF); const f32x4 v0 = acc[ai][bj][m][0], v1 = acc[ai][bj][m][1]; u32x4 w;
                    w.x = cvt_pk_bf16(v0[0] * bf_lo(g.x), v0[1] * bf_hi(g.x)); w.y = cvt_pk_bf16(v0[2] * bf_lo(g.y), v0[3] * bf_hi(g.y));
                    w.z = cvt_pk_bf16(v1[0] * bf_lo(g.z), v1[1] * bf_hi(g.z)); w.w = cvt_pk_bf16(v1[2] * bf_lo(g.w), v1[3] * bf_hi(g.w));
                    *(u32x4*)(op + bj * HALF) = w; } }
    }
};
struct EpiWout {
    static constexpr bool PERM = false, AFTER_DRAIN = false, HAS_MID = false; static constexpr int MID0 = -1, MID1 = -1;
    const float* x; float* out; bf16_t* x1b; float* ssq;
    __device__ __forceinline__ void operator()(const f32x4 (&acc)[2][2][4][2], const Unit& u, int wr, int wc, int fr, int fq) const {
        const int row0 = u.pm * BM + wr * 64 + fr, col0 = u.pn * BM + wc * 32 + 4 * fq;
#pragma unroll
        for (int ai = 0; ai < 2; ++ai)
#pragma unroll
            for (int m = 0; m < 4; ++m) { const int r = row0 + ai * HALF + m * 16; const size_t off = (size_t)r * 1024 + col0; float s = 0.f;
#pragma unroll
                for (int bj = 0; bj < 2; ++bj)
#pragma unroll
                    for (int n = 0; n < 2; ++n) { const f32x4 v = *(const f32x4*)(x + off + bj * HALF + n * 16) + acc[ai][bj][m][n];
                        *(f32x4*)(out + off + bj * HALF + n * 16) = v; u32x2 w; w.x = cvt_pk_bf16(v[0], v[1]); w.y = cvt_pk_bf16(v[2], v[3]); *(u32x2*)(x1b + off + bj * HALF + n * 16) = w;
                        s += (v[0] * v[0] + v[1] * v[1]) + (v[2] * v[2] + v[3] * v[3]); }
                s += __shfl_xor(s, 16); s += __shfl_xor(s, 32);
                if (fq == 0) ssq[(size_t)r * 16 + u.pn * 4 + wc] = s; }
    }
};
struct EpiFfnIn {
    static constexpr bool PERM = true, AFTER_DRAIN = false, HAS_MID = false; static constexpr int MID0 = -1, MID1 = -1;
    const float* ssq; bf16_t* U;
    __device__ __forceinline__ void operator()(const f32x4 (&acc)[2][2][4][2], const Unit& u, int wr, int wc, int fr, int fq) const {
        const int row0 = u.pm * BM + wr * 64 + fr, col0 = u.pn * 128 + wc * 32 + 8 * fq;
#pragma unroll
        for (int ai = 0; ai < 2; ++ai)
#pragma unroll
            for (int m = 0; m < 4; ++m) { const int r = row0 + ai * HALF + m * 16; const f32x4* sp = (const f32x4*)(ssq + (size_t)r * 16);
                const f32x4 s4 = (sp[0] + sp[1]) + (sp[2] + sp[3]); const float rs = __builtin_amdgcn_rsqf(((s4[0] + s4[1]) + (s4[2] + s4[3])) * (1.0f / 1024.0f) + 1e-6f);
                float o[8];
#pragma unroll
                for (int n = 0; n < 2; ++n)
#pragma unroll
                    for (int e = 0; e < 4; ++e) { const float a = acc[ai][0][m][n][e] * rs, b = acc[ai][1][m][n][e] * rs; o[4 * n + e] = a * sigmoid_f(a) * b; }
                u32x4 w; w.x = cvt_pk_bf16(o[0], o[1]); w.y = cvt_pk_bf16(o[2], o[3]); w.z = cvt_pk_bf16(o[4], o[5]); w.w = cvt_pk_bf16(o[6], o[7]);
                *(u32x4*)(U + (size_t)r * 2816 + col0) = w; }
    }
};
struct EpiFfnOut {
    static constexpr bool PERM = false, AFTER_DRAIN = false, HAS_MID = false; static constexpr int MID0 = -1, MID1 = -1;
    float* out;
    __device__ __forceinline__ void operator()(const f32x4 (&acc)[2][2][4][2], const Unit& u, int wr, int wc, int fr, int fq) const {
        const int row0 = u.pm * BM + wr * 64 + fr, col0 = u.pn * BM + wc * 32 + 4 * fq;
#pragma unroll
        for (int ai = 0; ai < 2; ++ai)
#pragma unroll
            for (int m = 0; m < 4; ++m) { float* rowp = out + (size_t)(row0 + ai * HALF + m * 16) * 1024 + col0;
#pragma unroll
                for (int bj = 0; bj < 2; ++bj)
#pragma unroll
                    for (int n = 0; n < 2; ++n) { f32x4* p = (f32x4*)(rowp + bj * HALF + n * 16); *p = *p + acc[ai][bj][m][n]; } }
    }
};
template <class Epi, class Sched, bool ALIGN_EPI = false, bool SP2 = false>
__device__ __forceinline__ void gemm_phase(PG8_LAS unsigned char* lds, const Gemm g, const Sched& S, const Epi& E) {
    int tid_ = threadIdx.x; asm volatile("" : "+v"(tid_));
    const int tid = tid_, wid = __builtin_amdgcn_readfirstlane(tid >> 6), lane = tid & 63, wr = wid >> 2, wc = wid & 3, fr = lane & 15, fq = lane >> 4;
    const int K = g.K, nt = K / BK;
    unsigned voffA[2], voffB[2];
#pragma unroll
    for (int i = 0; i < 2; ++i) { int R, C; stage_rc(tid * 16 + i * 8192, R, C); const int Rb = Epi::PERM ? ((R & ~31) + perm32(R & 31)) : R;
        voffA[i] = (unsigned)(R * K + C) * 2u; voffB[i] = (unsigned)(Rb * K + C) * 2u; }
    const size_t kstep = (size_t)(BK * 2);
    const size_t hstep = (size_t)HALF * K * 2;
    const size_t tstep = 2 * hstep;
    const unsigned ldsw = (unsigned)wid * 1024u;
    const int aoff = lds_byte(wr * 64 + fr, fq * 8), boff = lds_byte(wc * 32 + fr, fq * 8);
#define PG8_SA(b, h) (((b) * 2 + (h)) * HTB)
#define PG8_SB(b, h) ((4 + (b) * 2 + (h)) * HTB)
#define PG8_STAGE(bufoff, gbase, voff) do { _Pragma("unroll") for (int _i = 0; _i < 2; ++_i) \
        __builtin_amdgcn_global_load_lds((const unsigned*)((const char*)(gbase) + (voff)[_i]), (PG8_LAS unsigned*)(lds + (bufoff) + ldsw + _i * 8192), 16, 0, 0); } while (0)
#define PG8_LDA(dst, b, h) do { _Pragma("unroll") for (int m = 0; m < 4; ++m) _Pragma("unroll") for (int k = 0; k < 2; ++k) dst[m][k] = *(const PG8_LAS bf16x8*)(lds + PG8_SA(b, h) + aoff + m * 2048 + k * 1024); } while (0)
#define PG8_LDB(dst, b, h) do { _Pragma("unroll") for (int n = 0; n < 2; ++n) _Pragma("unroll") for (int k = 0; k < 2; ++k) dst[n][k] = *(const PG8_LAS bf16x8*)(lds + PG8_SB(b, h) + boff + n * 2048 + k * 1024); } while (0)
#define PG8_MMA(ai, bj, At, Bt) do { __builtin_amdgcn_s_setprio(1); _Pragma("unroll") for (int m = 0; m < 4; ++m) _Pragma("unroll") for (int n = 0; n < 2; ++n) _Pragma("unroll") for (int k = 0; k < 2; ++k) \
        acc[ai][bj][m][n] = __builtin_amdgcn_mfma_f32_16x16x32_bf16(Bt[n][k], At[m][k], acc[ai][bj][m][n], 0, 0, 0); __builtin_amdgcn_s_setprio(0); } while (0)
#define PG8_WAIT_V(n) asm volatile("s_waitcnt vmcnt(" #n ")" ::: "memory")
#define PG8_WAIT_L(n) asm volatile("s_waitcnt lgkmcnt(" #n ")" ::: "memory")
#define PG8_BAR __builtin_amdgcn_s_barrier()
#define PG8_SCHED __builtin_amdgcn_sched_barrier(0)
    Unit cur, nxt; int ui = 0;
    if (!S.next(0, cur)) return;
    f32x4 acc[2][2][4][2];
#pragma unroll
    for (int a = 0; a < 2; ++a)
#pragma unroll
        for (int b = 0; b < 2; ++b)
#pragma unroll
            for (int m = 0; m < 4; ++m)
#pragma unroll
                for (int n = 0; n < 2; ++n) acc[a][b][m][n] = (f32x4){0.f, 0.f, 0.f, 0.f};
    bf16x8 At[4][2], B0[2][2], B1[2][2];
    const char* cA = (const char*)g.A + (size_t)cur.pm * tstep; const char* cB = (const char*)g.Bt + (size_t)cur.pn * tstep;
    S.a_ready(cur);
    if constexpr (SP2) {
        PG8_STAGE(PG8_SB(0, 0), cB, voffB); PG8_STAGE(PG8_SB(0, 1), cB + hstep, voffB); PG8_STAGE(PG8_SA(0, 0), cA, voffA); PG8_STAGE(PG8_SA(0, 1), cA + hstep, voffA);
        if (wr == 1) PG8_BAR;
        PG8_WAIT_V(2); PG8_BAR;
        PG8_STAGE(PG8_SB(1, 0), cB + kstep, voffB); PG8_STAGE(PG8_SA(1, 0), cA + kstep, voffA); PG8_STAGE(PG8_SB(1, 1), cB + hstep + kstep, voffB);
        PG8_WAIT_V(6); PG8_BAR;
    } else {
        PG8_STAGE(PG8_SB(0, 0), cB, voffB); PG8_STAGE(PG8_SA(0, 0), cA, voffA); PG8_STAGE(PG8_SB(0, 1), cB + hstep, voffB); PG8_STAGE(PG8_SA(0, 1), cA + hstep, voffA);
        if (wr == 1) PG8_BAR;
        PG8_WAIT_V(4); PG8_BAR;
        PG8_STAGE(PG8_SB(1, 0), cB + kstep, voffB); PG8_STAGE(PG8_SA(1, 0), cA + kstep, voffA); PG8_STAGE(PG8_SB(1, 1), cB + hstep + kstep, voffB);
        PG8_WAIT_V(6); PG8_BAR;
    }
    for (;;) {
        const bool has_next = S.next(ui + 1, nxt);
        const char* nA = has_next ? (const char*)g.A + (size_t)nxt.pm * tstep : cA; const char* nB = has_next ? (const char*)g.Bt + (size_t)nxt.pn * tstep : cB;
        for (int t = 0; t < nt; t += 2) {
            if constexpr (Epi::HAS_MID) { if (t == Epi::MID0 || t == Epi::MID1) E.mid(acc, cur, t, wr, wc, fr, fq); }
            const bool last = (t == nt - 2);
            const char* a1 = cA + (size_t)(t + 1) * kstep;
            const char* a2 = last ? nA : cA + (size_t)(t + 2) * kstep; const char* b2 = last ? nB : cB + (size_t)(t + 2) * kstep;
            const char* a3 = a2 + kstep; const char* b3 = b2 + kstep;
            if (last && has_next) S.a_ready(nxt);
            if constexpr (SP2) {
            PG8_LDB(B0, 0, 0); PG8_LDB(B1, 0, 1); PG8_SCHED; PG8_LDA(At, 0, 0); PG8_STAGE(PG8_SA(1, 1), a1 + hstep, voffA);
            PG8_WAIT_V(8); PG8_WAIT_L(0); PG8_BAR; PG8_MMA(0, 0, At, B0); PG8_MMA(0, 1, At, B1); PG8_BAR; PG8_SCHED;
            PG8_LDA(At, 0, 1); PG8_STAGE(PG8_SB(0, 0), b2, voffB); PG8_STAGE(PG8_SB(0, 1), b2 + hstep, voffB); PG8_STAGE(PG8_SA(0, 0), a2, voffA);
            PG8_WAIT_V(8); PG8_WAIT_L(0); PG8_BAR; PG8_MMA(1, 0, At, B0); PG8_MMA(1, 1, At, B1); PG8_BAR; PG8_SCHED;
            PG8_LDB(B0, 1, 0); PG8_LDB(B1, 1, 1); PG8_SCHED; PG8_LDA(At, 1, 0); PG8_STAGE(PG8_SA(0, 1), a2 + hstep, voffA);
            PG8_WAIT_V(8); PG8_WAIT_L(0); PG8_BAR; PG8_MMA(0, 0, At, B0); PG8_MMA(0, 1, At, B1); PG8_BAR; PG8_SCHED;
            PG8_LDA(At, 1, 1); PG8_STAGE(PG8_SB(1, 0), b3, voffB); PG8_STAGE(PG8_SB(1, 1), b3 + hstep, voffB); PG8_STAGE(PG8_SA(1, 0), a3, voffA);
            PG8_WAIT_V(8); PG8_WAIT_L(0); PG8_BAR; PG8_MMA(1, 0, At, B0); PG8_MMA(1, 1, At, B1); PG8_BAR; PG8_SCHED;
            } else {
            PG8_LDB(B0, 0, 0); PG8_SCHED; PG8_LDA(At, 0, 0); PG8_STAGE(PG8_SA(1, 1), a1 + hstep, voffA);
            PG8_WAIT_L(8); PG8_BAR; PG8_WAIT_L(0); PG8_MMA(0, 0, At, B0); PG8_BAR; PG8_SCHED;
            PG8_LDB(B1, 0, 1); PG8_STAGE(PG8_SB(0, 0), b2, voffB);
            PG8_BAR; PG8_WAIT_L(0); PG8_MMA(0, 1, At, B1); PG8_BAR;
            PG8_LDA(At, 0, 1); PG8_STAGE(PG8_SA(0, 0), a2, voffA);
            PG8_BAR; PG8_WAIT_L(0); PG8_MMA(1, 0, At, B0); PG8_BAR; PG8_SCHED;
            PG8_STAGE(PG8_SB(0, 1), b2 + hstep, voffB);
            PG8_WAIT_V(6); PG8_BAR; PG8_MMA(1, 1, At, B1); PG8_BAR;
            PG8_LDB(B0, 1, 0); PG8_SCHED; PG8_LDA(At, 1, 0); PG8_STAGE(PG8_SA(0, 1), a2 + hstep, voffA);
            PG8_WAIT_L(8); PG8_BAR; PG8_WAIT_L(0); PG8_MMA(0, 0, At, B0); PG8_BAR; PG8_SCHED;
            PG8_LDB(B1, 1, 1); PG8_STAGE(PG8_SB(1, 0), b3, voffB);
            PG8_BAR; PG8_WAIT_L(0); PG8_MMA(0, 1, At, B1); PG8_BAR;
            PG8_LDA(At, 1, 1); PG8_STAGE(PG8_SA(1, 0), a3, voffA);
            PG8_BAR; PG8_WAIT_L(0); PG8_MMA(1, 0, At, B0); PG8_BAR; PG8_SCHED;
            PG8_STAGE(PG8_SB(1, 1), b3 + hstep, voffB);
            PG8_WAIT_V(6); PG8_BAR; PG8_MMA(1, 1, At, B1); PG8_BAR;
            }
        }
        if constexpr (ALIGN_EPI) { if (wr == 0) PG8_BAR; }
        if constexpr (!Epi::AFTER_DRAIN) { E(acc, cur, wr, wc, fr, fq); S.done(cur); }
        if (!has_next) break;
#pragma unroll
        for (int a = 0; a < 2; ++a)
#pragma unroll
            for (int b = 0; b < 2; ++b)
#pragma unroll
                for (int m = 0; m < 4; ++m)
#pragma unroll
                    for (int n = 0; n < 2; ++n) acc[a][b][m][n] = (f32x4){0.f, 0.f, 0.f, 0.f};
        cur = nxt; cA = nA; cB = nB; ++ui;
        if constexpr (ALIGN_EPI) { if (wr == 1) PG8_BAR; }
    }
    PG8_WAIT_V(0);
    if constexpr (!ALIGN_EPI) { if (wr == 0) PG8_BAR; }
    PG8_BAR;
    if constexpr (Epi::AFTER_DRAIN) { E.fused(acc, cur, wr, wc, fr, fq, lds, wid, lane); S.done(cur); }
#undef PG8_SA
#undef PG8_SB
#undef PG8_STAGE
#undef PG8_LDA
#undef PG8_LDB
#undef PG8_MMA
#undef PG8_WAIT_V
#undef PG8_WAIT_L
#undef PG8_BAR
#undef PG8_SCHED
}
}

constexpr int NWAVES = 8;
constexpr int D = 1024, BATCH = 8, SEQ = 4096, MTOK = BATCH * SEQ;
constexpr int NGRP = 2, GB = BATCH / NGRP, GR = GB * SEQ;
constexpr int NMEM = 256, INC = 13312, DFF = 2816;
constexpr float RMS_EPS = 1e-6f;
constexpr float ATT_SCALE = 0.08838834764831845f;

constexpr size_t MiB = 1u << 20;
constexpr size_t WS_CTL = 0, CTL_ZERO_BYTES = 1 * MiB;
constexpr size_t WS_WIN = 1 * MiB, WS_WFI = 27 * MiB, WS_WFO = 38 * MiB, WS_WPC = 44 * MiB, WS_WO = 48 * MiB, WS_WKV = 50 * MiB;
constexpr size_t WS_H = 52 * MiB;
constexpr size_t WS_HGQ = 116 * MiB, WS_LFF = 148 * MiB, WS_LFB = 180 * MiB, WS_HGV = 212 * MiB, WS_HGG = 244 * MiB;
constexpr size_t WS_DAQ = 276 * MiB, WS_DAK = 324 * MiB, WS_DAV = 372 * MiB;
constexpr size_t WS_MQ = 420 * MiB;
constexpr size_t WS_OCAT = 436 * MiB;
constexpr size_t WS_MEMKV = 500 * MiB;
constexpr size_t WS_MEMN = 504 * MiB;
constexpr size_t WS_LB = 508 * MiB;
constexpr size_t WS_SSQ = 509 * MiB;
constexpr size_t WS_END = 512 * MiB;
constexpr size_t WS_X1B = 116 * MiB;
constexpr size_t WS_U = 180 * MiB;
constexpr size_t OUT_GATES = 0, OUT_LSE = 96 * MiB;
constexpr int CW_BAR = 4096;
static_assert(pg8::EpiProj::O_HGQ == WS_HGQ && pg8::EpiProj::O_LFF == WS_LFF && pg8::EpiProj::O_LFB == WS_LFB && pg8::EpiProj::O_HGV == WS_HGV && pg8::EpiProj::O_HGG == WS_HGG && pg8::EpiProj::O_DAQ == WS_DAQ && pg8::EpiProj::O_DAK == WS_DAK && pg8::EpiProj::O_DAV == WS_DAV && pg8::EpiProj::O_MQ == WS_MQ, "EpiProj offsets");

constexpr int RING_OFF = 0, RING_BYTES = 131072;
constexpr int LDSCTL_OFF = RING_BYTES, MISC_OFF = LDSCTL_OFF + 320;
constexpr int LDS_BYTES = 147456;
#define GAS __attribute__((address_space(1)))
#define LAS __attribute__((address_space(3)))
typedef unsigned short bf16;
typedef unsigned v4u __attribute__((ext_vector_type(4)));
typedef float f32x4 __attribute__((ext_vector_type(4)));
typedef short bf16x8 __attribute__((ext_vector_type(8)));
typedef GAS unsigned gu32;
typedef GAS unsigned long long gu64;
#define RLX_AGENT __ATOMIC_RELAXED, __HIP_MEMORY_SCOPE_AGENT
#define LDS_WAIT() asm volatile("s_waitcnt lgkmcnt(0)" ::: "memory")
#define VM_WAIT() asm volatile("s_waitcnt vmcnt(0)" ::: "memory")
__device__ __forceinline__ unsigned long long rt() { return __builtin_amdgcn_s_memrealtime(); }
__device__ __forceinline__ unsigned f2bf(float f) { unsigned u = __builtin_bit_cast(unsigned, f); return (u + 0x7fffu + ((u >> 16) & 1u)) >> 16; }
__device__ __forceinline__ unsigned pk2(float lo, float hi) { return f2bf(lo) | (f2bf(hi) << 16); }

#define XB_TMO      128
#define XB_XCNT(j)  (256  + 64 * (j))
#define XB_XSUB(j)  (1280 + 64 * (j))
#define XB_XGEN(j)  (2304 + 64 * (j))
#define XB_TOP      3328
#define XB_TOPGEN   3392
#define XCD_BAR_WORDS 3456
#define XB_SPIN_CAP (1u << 18)

__device__ __forceinline__ unsigned xb_ld(unsigned* p)              { return __hip_atomic_load(p, __ATOMIC_RELAXED, __HIP_MEMORY_SCOPE_AGENT); }
__device__ __forceinline__ unsigned xb_add(unsigned* p, unsigned v) { return __hip_atomic_fetch_add(p, v, __ATOMIC_RELAXED, __HIP_MEMORY_SCOPE_AGENT); }
__device__ __forceinline__ unsigned xb_xcc_id() { return (unsigned)__builtin_amdgcn_s_getreg((3 << 11) | 20) & 0xFu; }
#define XB_SPIN(cond, bar) do { unsigned _sp = 0; while (cond) { __builtin_amdgcn_s_sleep(1); \
    if ((++_sp & 255u) == 0u) { if (xb_ld(&(bar)[XB_TMO])) break; if (_sp > XB_SPIN_CAP) { atomicAdd(&(bar)[XB_TMO], 1u); break; } } } } while (0)

struct XcdBarrier {
    unsigned* bar; unsigned x;
    volatile LAS unsigned* st;
};

__device__ __forceinline__ XcdBarrier xcd_barrier_post(unsigned* bar, volatile LAS unsigned* st) {
    XcdBarrier b; b.bar = bar; b.x = xb_xcc_id(); b.st = st;
    if (threadIdx.x == 0) (void)xb_add(&bar[XB_XCNT(b.x)], 1u);
    return b;
}
__device__ __forceinline__ void xcd_barrier_complete(unsigned* bar, unsigned x, unsigned& nloc, unsigned& nx) {
    const unsigned G = gridDim.x * gridDim.y * gridDim.z;
    unsigned sum, cnt, mine, sp = 0u;
    for (;;) {
        sum = 0u; cnt = 0u; mine = 0u;
#pragma unroll
        for (unsigned j = 0; j < 16; ++j) { const unsigned c = xb_ld(&bar[XB_XCNT(j)]); sum += c; cnt += (c > 0u) ? 1u : 0u; mine = (j == x) ? c : mine; }
        if (sum == G) break;
        __builtin_amdgcn_s_sleep(1);
        if ((++sp & 255u) == 0u) { if (xb_ld(&bar[XB_TMO])) break; if (sp > XB_SPIN_CAP) { atomicAdd(&bar[XB_TMO], 1u); break; } }
    }
    nloc = mine > 0u ? mine : 1u; nx = cnt > 0u ? cnt : 1u;
}

__device__ __forceinline__ void xcd_barrier(const XcdBarrier& b) {
    asm volatile("s_waitcnt vmcnt(0)" ::: "memory");
    __syncthreads();
    if (threadIdx.x == 0) {
        unsigned* bar = b.bar;
        __builtin_amdgcn_s_waitcnt(0);
        unsigned nloc = b.st[0], nx = b.st[1];
        if (nloc == 0u) { xcd_barrier_complete(bar, b.x, nloc, nx); b.st[0] = nloc; b.st[1] = nx; }
        const unsigned old = xb_add(&bar[XB_XSUB(b.x)], 1u);
        const unsigned gen = old / nloc;
        if (old + 1u == (gen + 1u) * nloc) {
            __builtin_amdgcn_fence(__ATOMIC_RELEASE, "agent");
            asm volatile("s_waitcnt vmcnt(0)" ::: "memory");
            const unsigned og = xb_add(&bar[XB_TOP], 1u);
            const unsigned tg = og / nx;
            if (og + 1u == (tg + 1u) * nx) xb_add(&bar[XB_TOPGEN], 1u);
            else XB_SPIN(xb_ld(&bar[XB_TOPGEN]) == tg, bar);
            __builtin_amdgcn_fence(__ATOMIC_ACQUIRE, "agent");
            xb_add(&bar[XB_XGEN(b.x)], 1u);
            asm volatile("s_waitcnt vmcnt(0)" ::: "memory");
        } else {
            XB_SPIN(xb_ld(&bar[XB_XGEN(b.x)]) == gen, bar);
            __builtin_amdgcn_fence(__ATOMIC_ACQUIRE, "agent");
            asm volatile("s_waitcnt vmcnt(0)" ::: "memory");
        }
    }
    __syncthreads();
}

struct Args { const float* in[20]; float* out; unsigned char* ws; int ph_lo, ph_hi; };
struct Frame {
    LAS unsigned char* lds;
    volatile LAS unsigned* MISC;
    gu32* ctl;
    int tid, lane, wave, vcu, G;
};
__device__ __forceinline__ float wave_sum(float v) {
#pragma unroll
    for (int o = 1; o < 64; o <<= 1) v += __shfl_xor(v, o);
    return v;
}
__device__ __forceinline__ float wave_max(float v) {
#pragma unroll
    for (int o = 1; o < 64; o <<= 1) v = fmaxf(v, __shfl_xor(v, o));
    return v;
}
__device__ __forceinline__ float bf2f(unsigned short b) { return __builtin_bit_cast(float, (unsigned)b << 16); }
__device__ __forceinline__ float h2f(unsigned short b) { return (float)__builtin_bit_cast(_Float16, b); }
__device__ __forceinline__ float blo(unsigned w) { return __builtin_bit_cast(float, w << 16); }
__device__ __forceinline__ float bhi(unsigned w) { return __builtin_bit_cast(float, w & 0xffff0000u); }

__device__ __forceinline__ void p0_transpose_item(const float* W, int N, bf16* WT, int ldk, int koff, int k0, int scol0, int drow0, const float* ks, LAS float* scr, int lane) {
#pragma unroll 8
    for (int i = 0; i < 32; ++i) { const int kk = 2 * i + (lane >> 5); float v = W[(size_t)(k0 + kk) * N + scol0 + (lane & 31)]; if (ks) v *= ks[k0 + kk]; scr[kk * 33 + (lane & 31)] = v; }
    LDS_WAIT(); asm volatile("" ::: "memory");
    const int c = lane & 7;
#pragma unroll
    for (int j = 0; j < 4; ++j) { const int n = (lane >> 3) + 8 * j; const LAS float* s = scr + (8 * c) * 33 + n;
        v4u o; o.x = pk2(s[0 * 33], s[1 * 33]); o.y = pk2(s[2 * 33], s[3 * 33]); o.z = pk2(s[4 * 33], s[5 * 33]); o.w = pk2(s[6 * 33], s[7 * 33]);
        *(GAS v4u*)(WT + (size_t)(drow0 + n) * ldk + koff + k0 + 8 * c) = o; }
    LDS_WAIT(); asm volatile("" ::: "memory");
}
__device__ __forceinline__ void p0_plain(const float* W, int K, int N, bf16* WT, int ldk, int koff, int item, LAS float* scr, int lane) {
    const int nblk = N / 32, kb = item / nblk, nb = item % nblk;
    p0_transpose_item(W, N, WT, ldk, koff, 64 * kb, 32 * nb, 32 * nb, nullptr, scr, lane);
}
__device__ __forceinline__ void rms_row_to_bf16(const float* xrow, const float* gain, bf16* orow, int lane) {
    const GAS f32x4* xr = (const GAS f32x4*)xrow + lane; const GAS f32x4* gr = (const GAS f32x4*)gain + lane;
    f32x4 v[4]; float s = 0.f;
#pragma unroll
    for (int j = 0; j < 4; ++j) { v[j] = xr[64 * j]; s += (v[j].x * v[j].x + v[j].y * v[j].y) + (v[j].z * v[j].z + v[j].w * v[j].w); }
    const float rs = 1.0f / sqrtf(wave_sum(s) * (1.f / 1024.f) + RMS_EPS);
    GAS unsigned long long* o8 = (GAS unsigned long long*)orow + lane;
#pragma unroll
    for (int j = 0; j < 4; ++j) { const f32x4 g = gr[64 * j]; o8[64 * j] = (unsigned long long)pk2(v[j].x * rs * g.x, v[j].y * rs * g.y) | ((unsigned long long)pk2(v[j].z * rs * g.z, v[j].w * rs * g.w) << 32); }
}
__device__ __forceinline__ void p0_prologue(Frame& F, const Args& A) {
    LAS float* scr = (LAS float*)(F.lds + RING_OFF + F.wave * 16384);
    const int gw = F.vcu * NWAVES + F.wave, NGW = F.G * NWAVES;
    bf16* WIN = (bf16*)(A.ws + WS_WIN); bf16* WFI = (bf16*)(A.ws + WS_WFI); bf16* WFO = (bf16*)(A.ws + WS_WFO); bf16* WPC = (bf16*)(A.ws + WS_WPC); bf16* WO = (bf16*)(A.ws + WS_WO); bf16* WKV = (bf16*)(A.ws + WS_WKV);
    constexpr int I_IN = 16 * (INC / 32), I_FI = 16 * (2 * DFF / 32), I_FO = (DFF / 64) * 32, I_PH = 16 * 32, I_PD = 8 * 32, I_PM = 8 * 32, I_O = 16 * 32, I_KV = 16 * 32;
    constexpr int NITEMS = I_IN + I_FI + I_FO + I_PH + I_PD + I_PM + I_O + I_KV;
    for (int it = gw; it < NITEMS; it += NGW) {
        int r = it;
        if (r < I_IN) { p0_plain(A.in[4], 1024, INC, WIN, 1024, 0, r, scr, F.lane); continue; } r -= I_IN;
        if (r < I_FI) {
            const int nblk = 2 * DFF / 32, kb = r / nblk, nb = r % nblk, d0 = 32 * nb, tile = d0 >> 8, within = d0 & 255;
            const int sc = within < 128 ? 128 * tile + within : DFF + 128 * tile + (within - 128);
            p0_transpose_item(A.in[18], 2 * DFF, WFI, 1024, 0, 64 * kb, sc, d0, A.in[17], scr, F.lane); continue; } r -= I_FI;
        if (r < I_FO) { p0_plain(A.in[19], DFF, 1024, WFO, DFF, 0, r, scr, F.lane); continue; } r -= I_FO;
        if (r < I_PH) { p0_plain(A.in[13], 1024, 1024, WPC, 2048, 0, r, scr, F.lane); continue; } r -= I_PH;
        if (r < I_PD) { p0_plain(A.in[14], 512, 1024, WPC, 2048, 1024, r, scr, F.lane); continue; } r -= I_PD;
        if (r < I_PM) { p0_plain(A.in[15], 512, 1024, WPC, 2048, 1536, r, scr, F.lane); continue; } r -= I_PM;
        if (r < I_O) { p0_plain(A.in[16], 1024, 1024, WO, 1024, 0, r, scr, F.lane); continue; } r -= I_O;
        p0_plain(A.in[10], 1024, 1024, WKV, 1024, 0, r, scr, F.lane);
    }
    bf16* H = (bf16*)(A.ws + WS_H); bf16* MEMN = (bf16*)(A.ws + WS_MEMN);
    for (int m = gw; m < MTOK; m += NGW) rms_row_to_bf16(A.in[0] + (size_t)m * D, A.in[2], H + (size_t)m * D, F.lane);
    for (int m = gw; m < BATCH * NMEM; m += NGW) rms_row_to_bf16(A.in[1] + (size_t)m * D, A.in[3], MEMN + (size_t)m * D, F.lane);
    float* LB = (float*)(A.ws + WS_LB);
    for (int i = gw * 64 + F.lane; i < 2048; i += NGW * 64) { const float* lg = (i < 1024) ? A.in[5] : A.in[6]; const int c = i & 1023; LB[i] = 1.0f / (1.0f + __expf(lg[1024 + c] - lg[c])); }
}

__device__ __forceinline__ void hgrn_simple(Frame& F, const Args& A, int sid) {
    const int bl = sid >> 4, h = (sid >> 1) & 7, dir = sid & 1, tid = F.tid, j = tid >> 2, iq = tid & 3;
    const size_t base = (size_t)bl * SEQ * 1024 + h * 128;
    const bf16* Q = (const bf16*)(A.ws + WS_HGQ) + base; const bf16* V = (const bf16*)(A.ws + WS_HGV) + base;
    bf16* LF = (bf16*)(A.ws + (dir ? WS_LFB : WS_LFF)) + base;
    LAS float* qs = (LAS float*)(F.lds); LAS float* fs = qs + 4096; LAS float* ks = fs + 4096; LAS float* vs = ks + 4096; LAS float* os = vs + 4096;
    float S[32];
#pragma unroll
    for (int i = 0; i < 32; ++i) S[i] = 0.f;
    for (int blk = 0; blk < SEQ / 32; ++blk) {
        const int t0 = dir ? (SEQ - 32 * (blk + 1)) : 32 * blk;
#pragma unroll
        for (int r = 0; r < 8; ++r) { const int e = tid + 512 * r, tt = e >> 7, i = e & 127; const size_t off = (size_t)(t0 + tt) * 1024 + i;
            const float f = __expf(h2f(LF[off])); qs[e] = bf2f(Q[off]); fs[e] = f; ks[e] = 1.0f - f; vs[e] = bf2f(V[off]); }
        __syncthreads();
        for (int s = 0; s < 32; ++s) { const int tt = dir ? 31 - s : s; const float vj = vs[tt * 128 + j]; float a = 0.f;
            const LAS f32x4* f4 = (const LAS f32x4*)(fs + tt * 128 + iq * 32); const LAS f32x4* k4 = (const LAS f32x4*)(ks + tt * 128 + iq * 32); const LAS f32x4* q4 = (const LAS f32x4*)(qs + tt * 128 + iq * 32);
#pragma unroll
            for (int c = 0; c < 8; ++c) { const f32x4 ff = f4[c], kk = k4[c], qq = q4[c];
#pragma unroll
                for (int e = 0; e < 4; ++e) { S[4 * c + e] = ff[e] * S[4 * c + e] + kk[e] * vj; a += S[4 * c + e] * qq[e]; } }
            a += __shfl_xor(a, 1); a += __shfl_xor(a, 2);
            if (iq == 0) os[tt * 128 + j] = a; }
        __syncthreads();
#pragma unroll
        for (int r = 0; r < 8; ++r) { const int e = tid + 512 * r, tt = e >> 7, i = e & 127; LF[(size_t)(t0 + tt) * 1024 + i] = (bf16)f2bf(os[e]); }
    }
    __syncthreads();
}
__device__ __forceinline__ void da_simple_item(Frame& F, const Args& A, int lrow, int hd, LAS float* wq) {
    const int lane = F.lane, bl = lrow >> 12, t = lrow & 4095, grp = hd >> 2, sh = 2 * grp, n = t >> sh, r = t & ((1 << sh) - 1), Ld = SEQ >> sh;
    bf16* qrow = (bf16*)(A.ws + WS_DAQ) + (size_t)lrow * 1536 + hd * 128;
    const bf16* K = (const bf16*)(A.ws + WS_DAK) + hd * 128; const bf16* V = (const bf16*)(A.ws + WS_DAV) + hd * 128;
    const unsigned qq = *(const unsigned*)(qrow + 2 * lane); const float q0 = blo(qq), q1 = bhi(qq);
    const float rq = 1.0f / sqrtf(wave_sum(q0 * q0 + q1 * q1) * (1.f / 128.f) + RMS_EPS);
    const float* gq = A.in[8]; const float* gk = A.in[9];
    wq[2 * lane] = q0 * rq * gq[2 * lane] * gk[2 * lane]; wq[2 * lane + 1] = q1 * rq * gq[2 * lane + 1] * gk[2 * lane + 1];
    LDS_WAIT(); asm volatile("" ::: "memory");
    const float slope = exp2f(-(float)(hd + 1) * (8.0f / 12.0f)) * (float)(1 << sh);
    float sc[3];
#pragma unroll
    for (int s = 0; s < 3; ++s) { const int kk = lane + 64 * s, rel = kk - 64, m = n + rel; const bool valid = (kk <= 128) && (m >= 0) && (m < Ld);
        float v = -INFINITY;
        if (valid) { const bf16* krow = K + (size_t)(bl * SEQ + (m << sh) + r) * 1536; float dot = 0.f, ssk = 0.f;
#pragma unroll 4
            for (int c = 0; c < 16; ++c) { const v4u kv = *(const v4u*)(krow + 8 * c); const LAS f32x4* w4 = (const LAS f32x4*)(wq + 8 * c); const f32x4 wa = w4[0], wb = w4[1];
                const float k0 = blo(kv.x), k1 = bhi(kv.x), k2 = blo(kv.y), k3 = bhi(kv.y), k4 = blo(kv.z), k5 = bhi(kv.z), k6 = blo(kv.w), k7 = bhi(kv.w);
                dot += (wa[0] * k0 + wa[1] * k1) + (wa[2] * k2 + wa[3] * k3) + (wb[0] * k4 + wb[1] * k5) + (wb[2] * k6 + wb[3] * k7);
                ssk += (k0 * k0 + k1 * k1) + (k2 * k2 + k3 * k3) + (k4 * k4 + k5 * k5) + (k6 * k6 + k7 * k7); }
            v = dot * (1.0f / sqrtf(ssk * (1.f / 128.f) + RMS_EPS)) * ATT_SCALE - slope * fabsf((float)rel); }
        sc[s] = v; }
    const float mx = wave_max(fmaxf(fmaxf(sc[0], sc[1]), sc[2]));
    float p[3];
#pragma unroll
    for (int s = 0; s < 3; ++s) p[s] = __expf(sc[s] - mx);
    const float sum = wave_sum(p[0] + p[1] + p[2]); const float inv = 1.0f / sum, lse = mx + __logf(sum);
    float o0 = 0.f, o1 = 0.f;
#pragma unroll
    for (int s = 0; s < 3; ++s) { const int cnt = (s < 2) ? 64 : 1;
        for (int c = 0; c < cnt; ++c) { const int kk = c + 64 * s, m = n + kk - 64; if (m < 0 || m >= Ld) continue;
            const float pj = __shfl(p[s], c) * inv; const unsigned vv = *(const unsigned*)(V + (size_t)(bl * SEQ + (m << sh) + r) * 1536 + 2 * lane);
            o0 += pj * blo(vv); o1 += pj * bhi(vv); } }
    *(unsigned*)(qrow + 2 * lane) = pk2(o0, o1);
    if (lane == 0) ((float*)((unsigned char*)A.out + OUT_LSE))[lrow * 12 + hd] = lse;
}
__device__ __forceinline__ void mem_simple_item(Frame& F, const Args& A, int g, int lrow, int hd, LAS float* wq) {
    const int lane = F.lane, b = g * GB + (lrow >> 12);
    const bf16* qrow = (const bf16*)(A.ws + WS_MQ) + (size_t)lrow * 512 + hd * 128;
    const bf16* K = (const bf16*)(A.ws + WS_MEMKV) + (size_t)b * NMEM * 1024 + hd * 128; const bf16* V = K + 512;
    const unsigned qq = *(const unsigned*)(qrow + 2 * lane); const float q0 = blo(qq), q1 = bhi(qq);
    const float rq = 1.0f / sqrtf(wave_sum(q0 * q0 + q1 * q1) * (1.f / 128.f) + RMS_EPS);
    const float* gq = A.in[11]; const float* gk = A.in[12];
    wq[2 * lane] = q0 * rq * gq[2 * lane] * gk[2 * lane]; wq[2 * lane + 1] = q1 * rq * gq[2 * lane + 1] * gk[2 * lane + 1];
    LDS_WAIT(); asm volatile("" ::: "memory");
    float sc[4];
#pragma unroll
    for (int s = 0; s < 4; ++s) { const bf16* krow = K + (size_t)(lane + 64 * s) * 1024; float dot = 0.f, ssk = 0.f;
#pragma unroll 4
        for (int c = 0; c < 16; ++c) { const v4u kv = *(const v4u*)(krow + 8 * c); const LAS f32x4* w4 = (const LAS f32x4*)(wq + 8 * c); const f32x4 wa = w4[0], wb = w4[1];
            const float k0 = blo(kv.x), k1 = bhi(kv.x), k2 = blo(kv.y), k3 = bhi(kv.y), k4 = blo(kv.z), k5 = bhi(kv.z), k6 = blo(kv.w), k7 = bhi(kv.w);
            dot += (wa[0] * k0 + wa[1] * k1) + (wa[2] * k2 + wa[3] * k3) + (wb[0] * k4 + wb[1] * k5) + (wb[2] * k6 + wb[3] * k7);
            ssk += (k0 * k0 + k1 * k1) + (k2 * k2 + k3 * k3) + (k4 * k4 + k5 * k5) + (k6 * k6 + k7 * k7); }
        sc[s] = dot * (1.0f / sqrtf(ssk * (1.f / 128.f) + RMS_EPS)) * ATT_SCALE; }
    const float mx = wave_max(fmaxf(fmaxf(sc[0], sc[1]), fmaxf(sc[2], sc[3])));
    float p[4];
#pragma unroll
    for (int s = 0; s < 4; ++s) p[s] = __expf(sc[s] - mx);
    const float inv = 1.0f / wave_sum((p[0] + p[1]) + (p[2] + p[3]));
    float o0 = 0.f, o1 = 0.f;
#pragma unroll
    for (int s = 0; s < 4; ++s)
        for (int c = 0; c < 64; ++c) { const float pj = __shfl(p[s], c) * inv; const unsigned vv = *(const unsigned*)(V + (size_t)(c + 64 * s) * 1024 + 2 * lane); o0 += pj * blo(vv); o1 += pj * bhi(vv); }
    *(unsigned*)((bf16*)(A.ws + WS_OCAT) + (size_t)lrow * 2048 + 1536 + hd * 128 + 2 * lane) = pk2(o0, o1);
}
__device__ __forceinline__ void p2_mixers_v1(Frame& F, const Args& A, int g) {
    constexpr int NHG = GB * 8 * 2;
    if ((int)blockIdx.x < NHG) { hgrn_simple(F, A, (int)blockIdx.x); return; }
    LAS float* wq = (LAS float*)(F.lds) + F.wave * 128;
    const int nw = (F.G - NHG) * NWAVES, gw = ((int)blockIdx.x - NHG) * NWAVES + F.wave;
    for (int it = gw; it < GR * 16; it += nw) { const int lrow = it >> 4, hh = it & 15;
        if (hh < 12) da_simple_item(F, A, lrow, hh, wq); else mem_simple_item(F, A, g, lrow, hh - 12, wq); }
}
__device__ __forceinline__ void p2_finalize_v1(Frame& F, const Args& A) {
    const int gw = F.vcu * NWAVES + F.wave, NGW = F.G * NWAVES, lane = F.lane;
    const bf16* OF = (const bf16*)(A.ws + WS_LFF); const bf16* OB = (const bf16*)(A.ws + WS_LFB); const bf16* GG = (const bf16*)(A.ws + WS_HGG);
    const bf16* DQ = (const bf16*)(A.ws + WS_DAQ); const float* LSE = (const float*)((unsigned char*)A.out + OUT_LSE); bf16* OC = (bf16*)(A.ws + WS_OCAT);
    const float g0 = A.in[7][2 * lane], g1 = A.in[7][2 * lane + 1];
    for (int row = gw; row < GR; row += NGW) {
#pragma unroll 2
        for (int h = 0; h < 8; ++h) { const size_t off = (size_t)row * 1024 + h * 128 + 2 * lane;
            const unsigned a = *(const unsigned*)(OF + off), b = *(const unsigned*)(OB + off), gg = *(const unsigned*)(GG + off);
            const float o0 = blo(a) + blo(b), o1 = bhi(a) + bhi(b); const float rs = 1.0f / sqrtf(wave_sum(o0 * o0 + o1 * o1) * (1.f / 128.f) + RMS_EPS);
            *(unsigned*)(OC + (size_t)row * 2048 + h * 128 + 2 * lane) = pk2(o0 * rs * g0 * blo(gg), o1 * rs * g1 * bhi(gg)); }
#pragma unroll
        for (int jj = 0; jj < 4; ++jj) { const float l0 = LSE[row * 12 + jj], l1 = LSE[row * 12 + 4 + jj], l2 = LSE[row * 12 + 8 + jj]; const float mx = fmaxf(fmaxf(l0, l1), l2);
            const float w0 = __expf(l0 - mx), w1 = __expf(l1 - mx), w2 = __expf(l2 - mx), inv = 1.0f / (w0 + w1 + w2);
            const unsigned a = *(const unsigned*)(DQ + (size_t)row * 1536 + jj * 128 + 2 * lane), b = *(const unsigned*)(DQ + (size_t)row * 1536 + (4 + jj) * 128 + 2 * lane), c = *(const unsigned*)(DQ + (size_t)row * 1536 + (8 + jj) * 128 + 2 * lane);
            *(unsigned*)(OC + (size_t)row * 2048 + 1024 + jj * 128 + 2 * lane) = pk2((w0 * blo(a) + w1 * blo(b) + w2 * blo(c)) * inv, (w0 * bhi(a) + w1 * bhi(b) + w2 * bhi(c)) * inv); }
    }
}

#ifndef MK_PER_PHASE
#define MK_PER_PHASE 0
#endif
constexpr int N_PHASES = 13;
__global__ void __launch_bounds__(NWAVES * 64, 2) mega_fwd(Args args) {
    extern __shared__ __attribute__((aligned(16))) unsigned char lds[];
    Frame F;
    F.lds = (LAS unsigned char*)lds;
    F.MISC = (volatile LAS unsigned*)(F.lds + MISC_OFF);
    F.tid = threadIdx.x; F.lane = F.tid & 63; F.wave = __builtin_amdgcn_readfirstlane(F.tid >> 6);
    F.G = gridDim.x; { const int bx = blockIdx.x; F.vcu = (F.G % 8 == 0) ? (bx % 8) * (F.G / 8) + bx / 8 : bx; }
    F.ctl = (gu32*)(args.ws + WS_CTL);
    for (int u = F.tid; u < (LDS_BYTES - LDSCTL_OFF) / 4; u += NWAVES * 64) ((LAS unsigned*)(F.lds + LDSCTL_OFF))[u] = 0u;
    __syncthreads();
    XcdBarrier bar; bar.bar = (unsigned*)(F.ctl + CW_BAR); bar.x = 0; bar.st = nullptr;
    if (!MK_PER_PHASE) bar = xcd_barrier_post((unsigned*)(F.ctl + CW_BAR), F.MISC + 8);
    const int lo = args.ph_lo, hi = args.ph_hi;
#ifndef PH_MASK
#define PH_MASK 0xFFF
#endif
#define PBIT(k) ((k) <= 4 ? (k) : ((k) <= 8 ? (k) - 4 : (k) - 4))
#define IN(k) (((PH_MASK >> PBIT(k)) & 1) && lo <= (k) && (k) < hi)
#define SEAM(k) do { if (IN(k) && IN((k) + 1)) xcd_barrier(bar); } while (0)
#if defined(__HIP_DEVICE_COMPILE__)
#define PHASE_ARGS() Args A; { const __attribute__((address_space(4))) Args* ap_ = (const __attribute__((address_space(4))) Args*)__builtin_amdgcn_kernarg_segment_ptr(); asm volatile("" : "+s"(ap_)); A = *ap_; } \
    unsigned char* const ws = A.ws; (void)ws; { int t_ = threadIdx.x; asm volatile("" : "+v"(t_)); F.tid = t_; F.lane = t_ & 63; F.wave = __builtin_amdgcn_readfirstlane(t_ >> 6); }
#else
#define PHASE_ARGS() Args A = args; unsigned char* const ws = A.ws; (void)ws
#endif

    if (IN(0)) { PHASE_ARGS(); p0_prologue(F, A); } SEAM(0);
    if (IN(1)) {
        PHASE_ARGS();
        pg8::Gemm gm{(const pg8::bf16_t*)(ws + WS_MEMN), (const pg8::bf16_t*)(ws + WS_WKV), BATCH * NMEM, 1024, 1024}; pg8::StaticOrder S; S.init(BATCH * NMEM, 1024, F.G, (int)blockIdx.x);
        pg8::EpiRaw E{(pg8::bf16_t*)(ws + WS_MEMKV), 1024};
        pg8::gemm_phase<pg8::EpiRaw, pg8::StaticOrder, true, true>(F.lds + RING_OFF, gm, S, E);
    }
    for (int g = 0; g < NGRP; ++g) {
        const int pb = 1 + 4 * g;
        if (IN(pb)) {
            PHASE_ARGS();
            pg8::Gemm gm{(const pg8::bf16_t*)(ws + WS_H) + (size_t)g * GR * 1024, (const pg8::bf16_t*)(ws + WS_WIN), GR, INC, 1024}; pg8::StaticOrder S; S.init(GR, INC, F.G, (int)blockIdx.x);
            pg8::EpiProj E{ws, (pg8::bf16_t*)((unsigned char*)A.out + OUT_GATES), (const float*)(ws + WS_LB)};
            pg8::gemm_phase<pg8::EpiProj, pg8::StaticOrder, true, true>(F.lds + RING_OFF, gm, S, E);
        }
        SEAM(pb);
        if (IN(pb + 1)) { PHASE_ARGS(); p2_mixers_v1(F, A, g); } SEAM(pb + 1);
        if (IN(pb + 2)) { PHASE_ARGS(); p2_finalize_v1(F, A); } SEAM(pb + 2);
        if (IN(pb + 3)) {
            PHASE_ARGS();
            pg8::Gemm gm{(const pg8::bf16_t*)(ws + WS_OCAT), (const pg8::bf16_t*)(ws + WS_WPC), GR, 1024, 2048}; pg8::StaticOrder S; S.init(GR, 1024, F.G, (int)blockIdx.x);
            pg8::EpiMerged E{(const pg8::bf16_t*)((unsigned char*)A.out + OUT_GATES), (pg8::bf16_t*)(ws + WS_H), g * GR};
            pg8::gemm_phase<pg8::EpiMerged, pg8::StaticOrder, true, true>(F.lds + RING_OFF, gm, S, E);
        }
        SEAM(pb + 3);
    }
    if (IN(9)) {
        PHASE_ARGS();
        pg8::Gemm gm{(const pg8::bf16_t*)(ws + WS_H), (const pg8::bf16_t*)(ws + WS_WO), MTOK, 1024, 1024}; pg8::StaticOrder S; S.init(MTOK, 1024, F.G, (int)blockIdx.x);
        pg8::EpiWout E{A.in[0], A.out, (pg8::bf16_t*)(ws + WS_X1B), (float*)(ws + WS_SSQ)};
        pg8::gemm_phase<pg8::EpiWout, pg8::StaticOrder, true, true>(F.lds + RING_OFF, gm, S, E);
    }
    SEAM(9);
    if (IN(10)) {
        PHASE_ARGS();
        pg8::Gemm gm{(const pg8::bf16_t*)(ws + WS_X1B), (const pg8::bf16_t*)(ws + WS_WFI), MTOK, 2 * DFF, 1024}; pg8::StaticOrder S; S.init(MTOK, 2 * DFF, F.G, (int)blockIdx.x);
        pg8::EpiFfnIn E{(const float*)(ws + WS_SSQ), (pg8::bf16_t*)(ws + WS_U)};
        pg8::gemm_phase<pg8::EpiFfnIn, pg8::StaticOrder, true, true>(F.lds + RING_OFF, gm, S, E);
    }
    SEAM(10);
    if (IN(11)) {
        PHASE_ARGS();
        pg8::Gemm gm{(const pg8::bf16_t*)(ws + WS_U), (const pg8::bf16_t*)(ws + WS_WFO), MTOK, 1024, DFF}; pg8::StaticOrder S; S.init(MTOK, 1024, F.G, (int)blockIdx.x);
        pg8::EpiFfnOut E{A.out};
        pg8::gemm_phase<pg8::EpiFfnOut, pg8::StaticOrder, true, true>(F.lds + RING_OFF, gm, S, E);
    }
#undef IN
#undef SEAM
}

extern "C" void kernel_launch(void* const* d_in, const int* in_sizes, int n_in, void* d_out, int out_size, void* d_ws, size_t ws_size, hipStream_t stream) {
    static int grid = 0;
    if (grid == 0) {
        if (n_in != 20 || in_sizes[0] != MTOK * D || out_size != MTOK * D || ws_size < WS_END) { fprintf(stderr, "kernel_launch: unexpected shapes/workspace: n_in %d in0 %d out %d ws %zu (need %zu); nothing launched\n", n_in, n_in > 0 ? in_sizes[0] : -1, out_size, ws_size, (size_t)WS_END); grid = -1; return; }
        int dev = 0, cus = 0, per_cu = 0;
        if (hipGetDevice(&dev) != hipSuccess || hipDeviceGetAttribute(&cus, hipDeviceAttributeMultiprocessorCount, dev) != hipSuccess) { grid = -1; return; }
        if (hipFuncSetAttribute((const void*)mega_fwd, hipFuncAttributeMaxDynamicSharedMemorySize, LDS_BYTES) != hipSuccess) { fprintf(stderr, "kernel_launch: hipFuncSetAttribute failed\n"); grid = -1; return; }
        if (hipOccupancyMaxActiveBlocksPerMultiprocessor(&per_cu, (const void*)mega_fwd, NWAVES * 64, LDS_BYTES) != hipSuccess || per_cu < 1) fprintf(stderr, "kernel_launch: occupancy query reports %d\n", per_cu);
        (void)hipGetLastError();
        grid = cus;
    }
    if (grid < 0) return;
    if (hipMemsetAsync((char*)d_ws + WS_CTL, 0, CTL_ZERO_BYTES, stream) != hipSuccess) { fprintf(stderr, "kernel_launch: memset failed\n"); return; }
    Args a{};
    for (int i = 0; i < 20; ++i) a.in[i] = (const float*)d_in[i];
    a.out = (float*)d_out; a.ws = (unsigned char*)d_ws;
#if MK_PER_PHASE
    for (int p = 0; p < 12; ++p) { a.ph_lo = p; a.ph_hi = p + 1; hipLaunchKernelGGL(mega_fwd, dim3(grid), dim3(NWAVES * 64), LDS_BYTES, stream, a); }
#else
    a.ph_lo = 0; a.ph_hi = 12; hipLaunchKernelGGL(mega_fwd, dim3(grid), dim3(NWAVES * 64), LDS_BYTES, stream, a);
#endif
}
```

```cpp
#include <hip/hip_runtime.h>
#include <cstdio>
#include <cstdint>
#include <cmath>
namespace pg8 {
#define PG8_LAS __attribute__((address_space(3)))
typedef unsigned short bf16_t;
typedef short bf16x8 __attribute__((ext_vector_type(8)));
typedef float f32x4 __attribute__((ext_vector_type(4)));
typedef unsigned u32x4 __attribute__((ext_vector_type(4)));
constexpr int BM = 256, BK = 64, HALF = 128, HTB = HALF * BK * 2  , STAGE_BYTES = 8 * HTB, NXCD = 8, WGM = 8;

__host__ __device__ __forceinline__ int lds_byte(int r, int c) { const int st = (r >> 4) * 2 + (c >> 5), rr = r & 15, cc = c & 31, ob = rr * 64 + cc * 2; return st * 1024 + (ob ^ (((ob >> 9) & 1) << 5)); }
__host__ __device__ __forceinline__ void stage_rc(int b, int& R, int& C) { const int st = b / 1024, sb = b % 1024, swz = sb ^ (((sb >> 9) & 1) << 5); R = (st >> 1) * 16 + swz / 64; C = (st & 1) * 32 + (swz % 64) / 2; }
__host__ __device__ __forceinline__ int perm32(int rho) { const int n = rho >> 4, i = rho & 15; return 8 * (i >> 2) + 4 * n + (i & 3); }

struct Unit { int pm, pn; };
struct Gemm { const bf16_t* A; const bf16_t* Bt; int M, N, K; };

struct StaticOrder {
    int nM, nN, nwg, G, c;
    __host__ __device__ void init(int M, int N, int G_, int c_) { nM = M / BM; nN = N / BM; nwg = nM * nN; G = G_; c = c_; }
    __host__ __device__ bool next(int i, Unit& u) const {
        const long L = (long)i * G + c; if (L >= nwg) return false;
        int wgid = (int)L; { const int q = nwg / NXCD, r = nwg % NXCD, xcd = wgid % NXCD, off = wgid / NXCD; wgid = (xcd < r ? xcd * (q + 1) : r * (q + 1) + (xcd - r) * q) + off; }
        const int nig = WGM * nN, gid = wgid / nig, fm = gid * WGM, gsz = (nM - fm) < WGM ? (nM - fm) : WGM;
        u.pm = fm + ((wgid % nig) % gsz); u.pn = (wgid % nig) / gsz; return true;
    }
    __device__ __forceinline__ void a_ready(const Unit&) const {}
    __device__ __forceinline__ void done(const Unit&) const {}
};

__device__ __forceinline__ unsigned cvt_pk_bf16(float lo, float hi) { unsigned r; asm volatile("v_cvt_pk_bf16_f32 %0, %1, %2" : "=v"(r) : "v"(lo), "v"(hi)); return r; }

typedef float f32x2 __attribute__((ext_vector_type(2)));
typedef unsigned u32x2 __attribute__((ext_vector_type(2)));
__device__ __forceinline__ float bf_lo(unsigned w) { return __builtin_bit_cast(float, w << 16); }
__device__ __forceinline__ float bf_hi(unsigned w) { return __builtin_bit_cast(float, w & 0xffff0000u); }
__device__ __forceinline__ float sigmoid_f(float v) { return __builtin_amdgcn_rcpf(1.0f + __expf(-v)); }
__device__ __forceinline__ float sig2(float vp) { return __builtin_amdgcn_rcpf(1.0f + __builtin_amdgcn_exp2f(vp)); }
__device__ __forceinline__ unsigned pk_f16(float lo, float hi) { const _Float16 a = (_Float16)lo, b = (_Float16)hi; return (unsigned)__builtin_bit_cast(unsigned short, a) | ((unsigned)__builtin_bit_cast(unsigned short, b) << 16); }

template <int MODE> __device__ __forceinline__ u32x4 pack8(f32x4 v0, f32x4 v1, f32x4 l0, f32x4 l1) {
    u32x4 w;
    if (MODE == 0) { w.x = cvt_pk_bf16(v0[0], v0[1]); w.y = cvt_pk_bf16(v0[2], v0[3]); w.z = cvt_pk_bf16(v1[0], v1[1]); w.w = cvt_pk_bf16(v1[2], v1[3]); }
    else {
        f32x4 e0, e1, s0, s1;
#pragma unroll
        for (int e = 0; e < 4; ++e) { e0[e] = __builtin_amdgcn_exp2f(v0[e]); e1[e] = __builtin_amdgcn_exp2f(v1[e]); }
        const f32x4 d0 = e0 + 1.0f, d1 = e1 + 1.0f;
#pragma unroll
        for (int e = 0; e < 4; ++e) { s0[e] = __builtin_amdgcn_rcpf(d0[e]); s1[e] = __builtin_amdgcn_rcpf(d1[e]); }
        if (MODE == 2) { const f32x4 f0 = l0 + (1.0f - l0) * s0, f1 = l1 + (1.0f - l1) * s1; float r[8];
#pragma unroll
            for (int e = 0; e < 4; ++e) { r[e] = __log2f(f0[e]); r[4 + e] = __log2f(f1[e]); }
            w.x = pk_f16(r[0], r[1]); w.y = pk_f16(r[2], r[3]); w.z = pk_f16(r[4], r[5]); w.w = pk_f16(r[6], r[7]);
        } else { f32x4 r0, r1;
            if (MODE == 1) { r0 = (v0 * (-0.6931471805599453f * 0.08838834764831845f)) * s0; r1 = (v1 * (-0.6931471805599453f * 0.08838834764831845f)) * s1; }
            else if (MODE == 3) { r0 = (v0 * -0.6931471805599453f) * s0; r1 = (v1 * -0.6931471805599453f) * s1; }
            else { r0 = __builtin_elementwise_max(s0, (f32x4){1e-20f, 1e-20f, 1e-20f, 1e-20f}); r1 = __builtin_elementwise_max(s1, (f32x4){1e-20f, 1e-20f, 1e-20f, 1e-20f}); }
            w.x = cvt_pk_bf16(r0[0], r0[1]); w.y = cvt_pk_bf16(r0[2], r0[3]); w.z = cvt_pk_bf16(r1[0], r1[1]); w.w = cvt_pk_bf16(r1[2], r1[3]); }
    }
    return w;
}
template <int MODE> __device__ __forceinline__ void store_tile(const f32x4 (&acc)[2][2][4][2], bf16_t* base, int ldc, int row0, int col0, const float* lb) {
    f32x4 l[2][2];
#pragma unroll
    for (int bj = 0; bj < 2; ++bj)
#pragma unroll
        for (int n = 0; n < 2; ++n) l[bj][n] = (MODE == 2) ? *(const f32x4*)(lb + col0 + bj * HALF + 4 * n) : (f32x4){0.f, 0.f, 0.f, 0.f};
#pragma unroll
    for (int ai = 0; ai < 2; ++ai)
#pragma unroll
        for (int m = 0; m < 4; ++m) { bf16_t* rowp = base + (size_t)(row0 + ai * HALF + m * 16) * ldc + col0;
#pragma unroll
            for (int bj = 0; bj < 2; ++bj) *(u32x4*)(rowp + bj * HALF) = pack8<MODE>(acc[ai][bj][m][0], acc[ai][bj][m][1], l[bj][0], l[bj][1]);
            asm volatile("" ::: "memory"); }
}

__device__ __forceinline__ void store_tile_norm(const f32x4 (&acc)[2][2][4][2], bf16_t* base, int ldc, int row0, int col0, const float* gain, float scale, PG8_LAS float* scr, int wr, int wc, int fr, int fq) {
#pragma unroll
    for (int ai = 0; ai < 2; ++ai)
#pragma unroll
        for (int m = 0; m < 4; ++m) { float s[2];
#pragma unroll
            for (int bj = 0; bj < 2; ++bj) { const f32x4 a = acc[ai][bj][m][0], b = acc[ai][bj][m][1], q = a * a + b * b;
                float t = (q[0] + q[1]) + (q[2] + q[3]);
                t += __shfl_xor(t, 16); t += __shfl_xor(t, 32); s[bj] = t; }
            if (fq == 0) { const int lr = ai * HALF + wr * 64 + m * 16 + fr; scr[(lr * 2 + 0) * 4 + wc] = s[0]; scr[(lr * 2 + 1) * 4 + wc] = s[1]; } }
    asm volatile("s_waitcnt lgkmcnt(0)" ::: "memory"); __builtin_amdgcn_s_barrier(); asm volatile("" ::: "memory");
    const f32x4 g0 = *(const f32x4*)(gain + wc * 32 + 8 * fq), g1 = *(const f32x4*)(gain + wc * 32 + 8 * fq + 4);
#pragma unroll
    for (int ai = 0; ai < 2; ++ai)
#pragma unroll
        for (int m = 0; m < 4; ++m) { const int lr = ai * HALF + wr * 64 + m * 16 + fr; bf16_t* rowp = base + (size_t)(row0 + ai * HALF + m * 16) * ldc + col0;
#pragma unroll
            for (int bj = 0; bj < 2; ++bj) { const f32x4 p = *(const PG8_LAS f32x4*)(scr + (lr * 2 + bj) * 4);
                const float rs = __builtin_amdgcn_rsqf(((p[0] + p[1]) + (p[2] + p[3])) * (1.0f / 128.0f) + 1e-6f) * scale;
                const f32x4 v0 = acc[ai][bj][m][0] * (g0 * rs), v1 = acc[ai][bj][m][1] * (g1 * rs); u32x4 w;
                w.x = cvt_pk_bf16(v0[0], v0[1]); w.y = cvt_pk_bf16(v0[2], v0[3]); w.z = cvt_pk_bf16(v1[0], v1[1]); w.w = cvt_pk_bf16(v1[2], v1[3]);
                *(u32x4*)(rowp + bj * HALF) = w; }
            asm volatile("" ::: "memory"); }
}

#ifndef GATE_RND
#define GATE_RND 0.0f
#endif
struct EpiProj {
    static constexpr bool PERM = true, AFTER_DRAIN = false, HAS_MID = false; static constexpr int MID0 = -1, MID1 = -1;
    unsigned char* ws; bf16_t* gates; const float* lb;
    const float *gq, *gk, *gmq; PG8_LAS float* scr;
    static constexpr float QSC = 0.08838834764831845f * 1.4426950408889634f;
    static constexpr size_t O_HGQ = 116ull << 20, O_LFF = 148ull << 20, O_LFB = 180ull << 20, O_HGV = 212ull << 20, O_HGG = 244ull << 20, O_DAQ = 276ull << 20, O_DAK = 324ull << 20, O_DAV = 372ull << 20, O_MQ = 420ull << 20;
    __device__ __forceinline__ void operator()(const f32x4 (&acc)[2][2][4][2], const Unit& u, int wr, int wc, int fr, int fq) const {
        const int pn = u.pn, row0 = u.pm * BM + wr * 64 + fr, cl = wc * 32 + 8 * fq;
        unsigned tw = 0u; const bool touch = !(pn >= 36 && pn < 40);
        if (touch) { const int pnn = pn + 4 >= 52 ? pn + 4 - 52 : pn + 4; tw = *(const unsigned*)(ws + (1ull << 20) + (size_t)pnn * 524288 + (size_t)(u.pm & 7) * 65536 + (size_t)(((wr * 4 + wc) * 64 + fq * 16 + fr) * 128)); }
        if (pn < 4)       store_tile<1>(acc, (bf16_t*)(ws + O_HGQ), 1024, row0, pn * 256 + cl, nullptr);
        else if (pn < 12) store_tile<2>(acc, (bf16_t*)(ws + (pn < 8 ? O_LFF : O_LFB)), 1024, row0, ((pn - 4) & 3) * 256 + cl, lb + (pn < 8 ? 0 : 1024));
        else if (pn < 20) { if (pn < 16) store_tile<0>(acc, (bf16_t*)(ws + O_HGV), 1024, row0, (pn - 12) * 256 + cl, nullptr); else store_tile<3>(acc, (bf16_t*)(ws + O_HGG), 1024, row0, (pn - 16) * 256 + cl, nullptr); }
        else if (pn < 32) { const bool isq = pn < 26; const int c0 = isq ? pn - 20 : pn - 26;
            store_tile_norm(acc, (bf16_t*)(ws + (isq ? O_DAQ : O_DAK)), 1536, row0, c0 * 256 + cl, isq ? gq : gk, isq ? QSC : 1.0f, scr, wr, wc, fr, fq); }
        else if (pn < 38) store_tile<0>(acc, (bf16_t*)(ws + O_DAV), 1536, row0, (pn - 32) * 256 + cl, nullptr);
        else if (pn < 40) store_tile_norm(acc, (bf16_t*)(ws + O_MQ), 512, row0, (pn - 38) * 256 + cl, gmq, QSC, scr, wr, wc, fr, fq);
        else {
            unsigned char* gt = (unsigned char*)gates + ((size_t)(((pn - 40) >> 2) * 64 + u.pm) * 4 + ((pn - 40) & 3)) * 65536 + (size_t)((wr * 4 + wc) * 16) * 512 + (fq * 16 + fr) * 8;
#pragma unroll
            for (int ai = 0; ai < 2; ++ai)
#pragma unroll
                for (int m = 0; m < 4; ++m) {
#pragma unroll
                    for (int bj = 0; bj < 2; ++bj) { u32x2 w = {0u, 0u};
#pragma unroll
                        for (int e = 0; e < 4; ++e) {
                            const float r0 = fmaxf(__builtin_amdgcn_rcpf(__builtin_fmaf(__builtin_amdgcn_exp2f(acc[ai][bj][m][0][e]), 1.0f / 255.0f, 1.0f / 255.0f)), 1.0f) + GATE_RND;
                            const float r1 = fmaxf(__builtin_amdgcn_rcpf(__builtin_fmaf(__builtin_amdgcn_exp2f(acc[ai][bj][m][1][e]), 1.0f / 255.0f, 1.0f / 255.0f)), 1.0f) + GATE_RND;
                            w.x = __builtin_amdgcn_cvt_pk_u8_f32(r0, e, w.x); w.y = __builtin_amdgcn_cvt_pk_u8_f32(r1, e, w.y); }
                        *(u32x2*)(gt + ((ai * 4 + m) * 2 + bj) * 512) = w; }
                    asm volatile("" ::: "memory"); } }
        if (touch && tw == 0x9e3779b9u) *(unsigned*)(ws + 8192) = tw;
    }
};
struct EpiKV {
    static constexpr bool PERM = true, AFTER_DRAIN = false, HAS_MID = false; static constexpr int MID0 = -1, MID1 = -1;
    bf16_t* O; const float* gk; PG8_LAS float* scr;
    __device__ __forceinline__ void operator()(const f32x4 (&acc)[2][2][4][2], const Unit& u, int wr, int wc, int fr, int fq) const {
        const int row0 = u.pm * BM + wr * 64 + fr, col0 = u.pn * 256 + wc * 32 + 8 * fq;
        if (u.pn < 2) store_tile_norm(acc, O, 1024, row0, col0, gk, 1.0f, scr, wr, wc, fr, fq);
        else          store_tile<0>(acc, O, 1024, row0, col0, nullptr);
    }
};
struct EpiMerged {
    static constexpr bool PERM = true, AFTER_DRAIN = false, HAS_MID = true; static constexpr int MID0 = 16, MID1 = 24;
    const bf16_t* gates; bf16_t* O; int row_off;
    static __device__ __forceinline__ float ub(unsigned w, int i) { return (float)((w >> (8 * i)) & 0xffu); }
    __device__ __forceinline__ void mid(f32x4 (&acc)[2][2][4][2], const Unit& u, int t, int wr, int wc, int fr, int fq) const {
        int wv = wr * 4 + wc, ln = fq * 16 + fr;
        asm volatile("" : "+v"(ln));
        const unsigned char* gp0 = (const unsigned char*)gates + ((size_t)((t == MID0 ? 0 : 1) * 64 + u.pm) * 4 + u.pn) * 65536 + (size_t)(wv * 16) * 512 + ln * 8;
#pragma unroll
        for (int ai = 0; ai < 2; ++ai)
#pragma unroll
            for (int m = 0; m < 4; ++m) {
#pragma unroll
                for (int bj = 0; bj < 2; ++bj) { const unsigned char* gp = gp0 + ((ai * 4 + m) * 2 + bj) * 512; const u32x2 a = *(const u32x2*)gp, b = *(const u32x2*)(gp + (size_t)64 * 4 * 65536);
                    f32x4 r0, r1;
#pragma unroll
                    for (int e = 0; e < 4; ++e) { r0[e] = ub(a.x, e) * __builtin_amdgcn_rcpf(ub(b.x, e)); r1[e] = ub(a.y, e) * __builtin_amdgcn_rcpf(ub(b.y, e)); }
                    acc[ai][bj][m][0] *= r0; acc[ai][bj][m][1] *= r1; }
                if (m == 3) asm volatile("" ::: "memory"); }
    }
    __device__ __forceinline__ void operator()(const f32x4 (&acc)[2][2][4][2], const Unit& u, int wr, int wc, int fr, int fq) const {
        const int row0 = u.pm * BM + wr * 64 + fr, col0 = u.pn * BM + wc * 32 + 8 * fq;
        const unsigned char* gp0 = (const unsigned char*)gates + ((size_t)(2 * 64 + u.pm) * 4 + u.pn) * 65536 + (size_t)((wr * 4 + wc) * 16) * 512 + (fq * 16 + fr) * 8;
#pragma unroll
        for (int ai = 0; ai < 2; ++ai)
#pragma unroll
            for (int m = 0; m < 4; ++m) { const int r = row0 + ai * HALF + m * 16; bf16_t* op = O + (size_t)(row_off + r) * 1024 + col0;
#pragma unroll
                for (int bj = 0; bj < 2; ++bj) { const u32x2 g = *(const u32x2*)(gp0 + ((ai * 4 + m) * 2 + bj) * 512); const f32x4 v0 = acc[ai][bj][m][0] * (1.0f / 255.0f), v1 = acc[ai][bj][m][1] * (1.0f / 255.0f); u32x4 w;
                    w.x = cvt_pk_bf16(v0[0] * ub(g.x, 0), v0[1] * ub(g.x, 1)); w.y = cvt_pk_bf16(v0[2] * ub(g.x, 2), v0[3] * ub(g.x, 3));
                    w.z = cvt_pk_bf16(v1[0] * ub(g.y, 0), v1[1] * ub(g.y, 1)); w.w = cvt_pk_bf16(v1[2] * ub(g.y, 2), v1[3] * ub(g.y, 3));
                    *(u32x4*)(op + bj * HALF) = w; } }
    }
};
struct EpiWout {
    static constexpr bool PERM = false, AFTER_DRAIN = false, HAS_MID = false; static constexpr int MID0 = -1, MID1 = -1;
    const float* x; bf16_t* x1b; float* ssq;
    __device__ __forceinline__ void operator()(const f32x4 (&acc)[2][2][4][2], const Unit& u, int wr, int wc, int fr, int fq) const {
        const int row0 = u.pm * BM + wr * 64 + fr, col0 = u.pn * BM + wc * 32 + 4 * fq;
#pragma unroll
        for (int ai = 0; ai < 2; ++ai)
#pragma unroll
            for (int m = 0; m < 4; ++m) { const int r = row0 + ai * HALF + m * 16; const size_t off = (size_t)r * 1024 + col0; float s = 0.f;
#pragma unroll
                for (int bj = 0; bj < 2; ++bj)
#pragma unroll
                    for (int n = 0; n < 2; ++n) { const f32x4 v = *(const f32x4*)(x + off + bj * HALF + n * 16) + acc[ai][bj][m][n];
                        u32x2 w; w.x = cvt_pk_bf16(v[0], v[1]); w.y = cvt_pk_bf16(v[2], v[3]); *(u32x2*)(x1b + off + bj * HALF + n * 16) = w;
                        s += (v[0] * v[0] + v[1] * v[1]) + (v[2] * v[2] + v[3] * v[3]); }
                s += __shfl_xor(s, 16); s += __shfl_xor(s, 32);
                if (fq == 0) ssq[(size_t)r * 16 + u.pn * 4 + wc] = s; }
    }
};
struct EpiFfnIn {
    static constexpr bool PERM = true, AFTER_DRAIN = false, HAS_MID = false; static constexpr int MID0 = -1, MID1 = -1;
    const float* ssq; bf16_t* U;
    PG8_LAS float* cache;
    __device__ __forceinline__ void operator()(const f32x4 (&acc)[2][2][4][2], const Unit& u, int wr, int wc, int fr, int fq) const {
        const int row0 = u.pm * BM + wr * 64 + fr, col0 = u.pn * 128 + wc * 32 + 8 * fq;
        PG8_LAS float* cw = cache + (wr * 4 + wc) * 132;
        float rsv[2][4];
        if (__builtin_amdgcn_readfirstlane(((volatile PG8_LAS int*)cw)[128]) != u.pm + 1) {
#pragma unroll
            for (int ai = 0; ai < 2; ++ai)
#pragma unroll
                for (int m = 0; m < 4; ++m) { const int r = row0 + ai * HALF + m * 16; const f32x4* sp = (const f32x4*)(ssq + (size_t)r * 16);
                    const f32x4 s4 = (sp[0] + sp[1]) + (sp[2] + sp[3]); rsv[ai][m] = __builtin_amdgcn_rsqf(((s4[0] + s4[1]) + (s4[2] + s4[3])) * (1.0f / 1024.0f) + 1e-6f);
                    if (fq == 0) cw[(ai * 4 + m) * 16 + fr] = rsv[ai][m]; }
            if (fq == 0 && fr == 0) ((volatile PG8_LAS int*)cw)[128] = u.pm + 1;
        } else {
#pragma unroll
            for (int ai = 0; ai < 2; ++ai)
#pragma unroll
                for (int m = 0; m < 4; ++m) rsv[ai][m] = cw[(ai * 4 + m) * 16 + fr];
        }
#pragma unroll
        for (int ai = 0; ai < 2; ++ai)
#pragma unroll
            for (int m = 0; m < 4; ++m) { const int r = row0 + ai * HALF + m * 16; const float rs = rsv[ai][m], nrs = rs * -1.4426950408889634f, rs2 = rs * rs;
                f32x4 o[2];
#pragma unroll
                for (int n = 0; n < 2; ++n) { const f32x4 t = acc[ai][0][m][n] * nrs, p = acc[ai][0][m][n] * acc[ai][1][m][n]; f32x4 ex, rc;
#pragma unroll
                    for (int e = 0; e < 4; ++e) ex[e] = __builtin_amdgcn_exp2f(t[e]);
                    const f32x4 d = ex + 1.0f;
#pragma unroll
                    for (int e = 0; e < 4; ++e) rc[e] = __builtin_amdgcn_rcpf(d[e]);
                    o[n] = p * (rc * rs2); }
                u32x4 w; w.x = cvt_pk_bf16(o[0][0], o[0][1]); w.y = cvt_pk_bf16(o[0][2], o[0][3]); w.z = cvt_pk_bf16(o[1][0], o[1][1]); w.w = cvt_pk_bf16(o[1][2], o[1][3]);
                *(u32x4*)(U + (size_t)r * 2816 + col0) = w; }
    }
};
struct EpiFfnOut {
    static constexpr bool PERM = false, AFTER_DRAIN = false, HAS_MID = false; static constexpr int MID0 = -1, MID1 = -1;
    const bf16_t* x1b; float* out;
    __device__ __forceinline__ void operator()(const f32x4 (&acc)[2][2][4][2], const Unit& u, int wr, int wc, int fr, int fq) const {
        const int row0 = u.pm * BM + wr * 64 + fr, col0 = u.pn * BM + wc * 32 + 4 * fq;
#pragma unroll
        for (int ai = 0; ai < 2; ++ai)
#pragma unroll
            for (int m = 0; m < 4; ++m) { const size_t off = (size_t)(row0 + ai * HALF + m * 16) * 1024 + col0;
#pragma unroll
                for (int bj = 0; bj < 2; ++bj)
#pragma unroll
                    for (int n = 0; n < 2; ++n) { const u32x2 w = *(const u32x2*)(x1b + off + bj * HALF + n * 16); f32x4 v; v[0] = bf_lo(w.x); v[1] = bf_hi(w.x); v[2] = bf_lo(w.y); v[3] = bf_hi(w.y);
                        *(f32x4*)(out + off + bj * HALF + n * 16) = v + acc[ai][bj][m][n]; } }
    }
};
template <class Epi, class Sched, bool ALIGN_EPI = false, bool SP2 = false>
__device__ __forceinline__ void gemm_phase(PG8_LAS unsigned char* lds, const Gemm g, const Sched& S, const Epi& E, int tid_in) {
    int tid_ = tid_in; asm volatile("" : "+v"(tid_));
    const int tid = tid_, wid = __builtin_amdgcn_readfirstlane(tid >> 6), lane = tid & 63, wr = wid >> 2, wc = wid & 3, fr = lane & 15, fq = lane >> 4;
    const int K = g.K, nt = K / BK;
    unsigned voffA[2], voffB[2];
#pragma unroll
    for (int i = 0; i < 2; ++i) { int R, C; stage_rc(tid * 16 + i * 8192, R, C); const int Rb = Epi::PERM ? ((R & ~31) + perm32(R & 31)) : R;
        voffA[i] = (unsigned)(R * K + C) * 2u; voffB[i] = (unsigned)(Rb * K + C) * 2u; }
    const size_t kstep = (size_t)(BK * 2);
    const size_t hstep = (size_t)HALF * K * 2;
    const size_t tstep = 2 * hstep;
    const unsigned ldsw = (unsigned)wid * 1024u;
    const int aoff = lds_byte(wr * 64 + fr, fq * 8), boff = lds_byte(wc * 32 + fr, fq * 8);
#define PG8_SA(b, h) (((b) * 2 + (h)) * HTB)
#define PG8_SB(b, h) ((4 + (b) * 2 + (h)) * HTB)
#define PG8_STAGE(bufoff, gbase, voff) do { _Pragma("unroll") for (int _i = 0; _i < 2; ++_i) \
        __builtin_amdgcn_global_load_lds((const unsigned*)((const char*)(gbase) + (voff)[_i]), (PG8_LAS unsigned*)(lds + (bufoff) + ldsw + _i * 8192), 16, 0, 0); } while (0)
#define PG8_LDA(dst, b, h) do { _Pragma("unroll") for (int m = 0; m < 4; ++m) _Pragma("unroll") for (int k = 0; k < 2; ++k) dst[m][k] = *(const PG8_LAS bf16x8*)(lds + PG8_SA(b, h) + aoff + m * 2048 + k * 1024); } while (0)
#define PG8_LDB(dst, b, h) do { _Pragma("unroll") for (int n = 0; n < 2; ++n) _Pragma("unroll") for (int k = 0; k < 2; ++k) dst[n][k] = *(const PG8_LAS bf16x8*)(lds + PG8_SB(b, h) + boff + n * 2048 + k * 1024); } while (0)
#define PG8_MMA(ai, bj, At, Bt) do { __builtin_amdgcn_s_setprio(1); _Pragma("unroll") for (int m = 0; m < 4; ++m) _Pragma("unroll") for (int n = 0; n < 2; ++n) _Pragma("unroll") for (int k = 0; k < 2; ++k) \
        acc[ai][bj][m][n] = __builtin_amdgcn_mfma_f32_16x16x32_bf16(Bt[n][k], At[m][k], acc[ai][bj][m][n], 0, 0, 0); __builtin_amdgcn_s_setprio(0); } while (0)
#define PG8_WAIT_V(n) asm volatile("s_waitcnt vmcnt(" #n ")" ::: "memory")
#define PG8_WAIT_L(n) asm volatile("s_waitcnt lgkmcnt(" #n ")" ::: "memory")
#define PG8_BAR __builtin_amdgcn_s_barrier()
#define PG8_SCHED __builtin_amdgcn_sched_barrier(0)
    Unit cur, nxt; int ui = 0;
    if (!S.next(0, cur)) return;
    f32x4 acc[2][2][4][2];
#pragma unroll
    for (int a = 0; a < 2; ++a)
#pragma unroll
        for (int b = 0; b < 2; ++b)
#pragma unroll
            for (int m = 0; m < 4; ++m)
#pragma unroll
                for (int n = 0; n < 2; ++n) acc[a][b][m][n] = (f32x4){0.f, 0.f, 0.f, 0.f};
    bf16x8 At[4][2], B0[2][2], B1[2][2];
    const char* cA = (const char*)g.A + (size_t)cur.pm * tstep; const char* cB = (const char*)g.Bt + (size_t)cur.pn * tstep;
    S.a_ready(cur);
    if constexpr (SP2) {
        PG8_STAGE(PG8_SB(0, 0), cB, voffB); PG8_STAGE(PG8_SB(0, 1), cB + hstep, voffB); PG8_STAGE(PG8_SA(0, 0), cA, voffA); PG8_STAGE(PG8_SA(0, 1), cA + hstep, voffA);
        if (wr == 1) PG8_BAR;
        PG8_WAIT_V(2); PG8_BAR;
        PG8_STAGE(PG8_SB(1, 0), cB + kstep, voffB); PG8_STAGE(PG8_SA(1, 0), cA + kstep, voffA); PG8_STAGE(PG8_SB(1, 1), cB + hstep + kstep, voffB);
        PG8_WAIT_V(6); PG8_BAR;
    } else {
        PG8_STAGE(PG8_SB(0, 0), cB, voffB); PG8_STAGE(PG8_SA(0, 0), cA, voffA); PG8_STAGE(PG8_SB(0, 1), cB + hstep, voffB); PG8_STAGE(PG8_SA(0, 1), cA + hstep, voffA);
        if (wr == 1) PG8_BAR;
        PG8_WAIT_V(4); PG8_BAR;
        PG8_STAGE(PG8_SB(1, 0), cB + kstep, voffB); PG8_STAGE(PG8_SA(1, 0), cA + kstep, voffA); PG8_STAGE(PG8_SB(1, 1), cB + hstep + kstep, voffB);
        PG8_WAIT_V(6); PG8_BAR;
    }
    for (;;) {
        const bool has_next = S.next(ui + 1, nxt);
        const char* nA = has_next ? (const char*)g.A + (size_t)nxt.pm * tstep : cA; const char* nB = has_next ? (const char*)g.Bt + (size_t)nxt.pn * tstep : cB;
        for (int t = 0; t < nt; t += 2) {
            if constexpr (Epi::HAS_MID) { if (t == Epi::MID0 || t == Epi::MID1) E.mid(acc, cur, t, wr, wc, fr, fq); }
            const bool last = (t == nt - 2);
            const char* a1 = cA + (size_t)(t + 1) * kstep;
            const char* a2 = last ? nA : cA + (size_t)(t + 2) * kstep; const char* b2 = last ? nB : cB + (size_t)(t + 2) * kstep;
            const char* a3 = a2 + kstep; const char* b3 = b2 + kstep;
            if (last && has_next) S.a_ready(nxt);
            if constexpr (SP2) {
            PG8_LDB(B0, 0, 0); PG8_LDB(B1, 0, 1); PG8_SCHED; PG8_LDA(At, 0, 0); PG8_STAGE(PG8_SA(1, 1), a1 + hstep, voffA);
            PG8_WAIT_V(8); PG8_WAIT_L(0); PG8_BAR; PG8_MMA(0, 0, At, B0); PG8_MMA(0, 1, At, B1); PG8_BAR; PG8_SCHED;
            PG8_LDA(At, 0, 1); PG8_STAGE(PG8_SB(0, 0), b2, voffB); PG8_STAGE(PG8_SB(0, 1), b2 + hstep, voffB); PG8_STAGE(PG8_SA(0, 0), a2, voffA);
            PG8_WAIT_V(8); PG8_WAIT_L(0); PG8_BAR; PG8_MMA(1, 0, At, B0); PG8_MMA(1, 1, At, B1); PG8_BAR; PG8_SCHED;
            PG8_LDB(B0, 1, 0); PG8_LDB(B1, 1, 1); PG8_SCHED; PG8_LDA(At, 1, 0); PG8_STAGE(PG8_SA(0, 1), a2 + hstep, voffA);
            PG8_WAIT_V(8); PG8_WAIT_L(0); PG8_BAR; PG8_MMA(0, 0, At, B0); PG8_MMA(0, 1, At, B1); PG8_BAR; PG8_SCHED;
            PG8_LDA(At, 1, 1); PG8_STAGE(PG8_SB(1, 0), b3, voffB); PG8_STAGE(PG8_SB(1, 1), b3 + hstep, voffB); PG8_STAGE(PG8_SA(1, 0), a3, voffA);
            PG8_WAIT_V(8); PG8_WAIT_L(0); PG8_BAR; PG8_MMA(1, 0, At, B0); PG8_MMA(1, 1, At, B1); PG8_BAR; PG8_SCHED;
            } else {
            PG8_LDB(B0, 0, 0); PG8_SCHED; PG8_LDA(At, 0, 0); PG8_STAGE(PG8_SA(1, 1), a1 + hstep, voffA);
            PG8_WAIT_L(8); PG8_BAR; PG8_WAIT_L(0); PG8_MMA(0, 0, At, B0); PG8_BAR; PG8_SCHED;
            PG8_LDB(B1, 0, 1); PG8_STAGE(PG8_SB(0, 0), b2, voffB);
            PG8_BAR; PG8_WAIT_L(0); PG8_MMA(0, 1, At, B1); PG8_BAR;
            PG8_LDA(At, 0, 1); PG8_STAGE(PG8_SA(0, 0), a2, voffA);
            PG8_BAR; PG8_WAIT_L(0); PG8_MMA(1, 0, At, B0); PG8_BAR; PG8_SCHED;
            PG8_STAGE(PG8_SB(0, 1), b2 + hstep, voffB);
            PG8_WAIT_V(6); PG8_BAR; PG8_MMA(1, 1, At, B1); PG8_BAR;
            PG8_LDB(B0, 1, 0); PG8_SCHED; PG8_LDA(At, 1, 0); PG8_STAGE(PG8_SA(0, 1), a2 + hstep, voffA);
            PG8_WAIT_L(8); PG8_BAR; PG8_WAIT_L(0); PG8_MMA(0, 0, At, B0); PG8_BAR; PG8_SCHED;
            PG8_LDB(B1, 1, 1); PG8_STAGE(PG8_SB(1, 0), b3, voffB);
            PG8_BAR; PG8_WAIT_L(0); PG8_MMA(0, 1, At, B1); PG8_BAR;
            PG8_LDA(At, 1, 1); PG8_STAGE(PG8_SA(1, 0), a3, voffA);
            PG8_BAR; PG8_WAIT_L(0); PG8_MMA(1, 0, At, B0); PG8_BAR; PG8_SCHED;
            PG8_STAGE(PG8_SB(1, 1), b3 + hstep, voffB);
            PG8_WAIT_V(6); PG8_BAR; PG8_MMA(1, 1, At, B1); PG8_BAR;
            }
        }
        if constexpr (ALIGN_EPI) { if (wr == 0) PG8_BAR; }
        if constexpr (!Epi::AFTER_DRAIN) { E(acc, cur, wr, wc, fr, fq); S.done(cur); }
        if (!has_next) break;
#pragma unroll
        for (int a = 0; a < 2; ++a)
#pragma unroll
            for (int b = 0; b < 2; ++b)
#pragma unroll
                for (int m = 0; m < 4; ++m)
#pragma unroll
                    for (int n = 0; n < 2; ++n) acc[a][b][m][n] = (f32x4){0.f, 0.f, 0.f, 0.f};
        cur = nxt; cA = nA; cB = nB; ++ui;
        if constexpr (ALIGN_EPI) { if (wr == 1) PG8_BAR; }
    }
    PG8_WAIT_V(0);
    if constexpr (!ALIGN_EPI) { if (wr == 0) PG8_BAR; }
    PG8_BAR;
    if constexpr (Epi::AFTER_DRAIN) { E.fused(acc, cur, wr, wc, fr, fq, lds, wid, lane); S.done(cur); }
#undef PG8_SA
#undef PG8_SB
#undef PG8_STAGE
#undef PG8_LDA
#undef PG8_LDB
#undef PG8_MMA
#undef PG8_WAIT_V
#undef PG8_WAIT_L
#undef PG8_BAR
#undef PG8_SCHED
}
}

constexpr int NWAVES = 8;
constexpr int D = 1024, BATCH = 8, SEQ = 4096, MTOK = BATCH * SEQ;
constexpr int NGRP = 2, GB = BATCH / NGRP, GR = GB * SEQ;
constexpr int NMEM = 256, INC = 13312, DFF = 2816;
constexpr float RMS_EPS = 1e-6f;
constexpr float ATT_SCALE = 0.08838834764831845f;

constexpr size_t MiB = 1u << 20;
constexpr size_t WS_CTL = 0, CTL_ZERO_BYTES = 1 * MiB;
constexpr size_t WS_WIN = 1 * MiB, WS_WFI = 27 * MiB, WS_WFO = 38 * MiB, WS_WPC = 44 * MiB, WS_WO = 48 * MiB, WS_WKV = 50 * MiB;
constexpr size_t WS_H = 52 * MiB;
constexpr size_t WS_HGQ = 116 * MiB, WS_LFF = 148 * MiB, WS_LFB = 180 * MiB, WS_HGV = 212 * MiB, WS_HGG = 244 * MiB;
constexpr size_t WS_DAQ = 276 * MiB, WS_DAK = 324 * MiB, WS_DAV = 372 * MiB;
constexpr size_t WS_MQ = 420 * MiB;
constexpr size_t WS_OCAT = 436 * MiB;
constexpr size_t WS_MEMKV = 500 * MiB;
constexpr size_t WS_MEMN = 504 * MiB;
constexpr size_t WS_LB = 508 * MiB;
constexpr size_t WS_SSQ = 509 * MiB;
constexpr size_t WS_END = 512 * MiB;
constexpr size_t WS_X1B = 116 * MiB;
constexpr size_t WS_U = 180 * MiB;
constexpr size_t OUT_GATES = 0, OUT_SL = 96 * MiB;
constexpr size_t WS_LSE = 508 * MiB + 65536;
constexpr size_t WS_DT = 511 * MiB;
constexpr int CW_BAR = 4096;
static_assert(pg8::EpiProj::O_HGQ == WS_HGQ && pg8::EpiProj::O_LFF == WS_LFF && pg8::EpiProj::O_LFB == WS_LFB && pg8::EpiProj::O_HGV == WS_HGV && pg8::EpiProj::O_HGG == WS_HGG && pg8::EpiProj::O_DAQ == WS_DAQ && pg8::EpiProj::O_DAK == WS_DAK && pg8::EpiProj::O_DAV == WS_DAV && pg8::EpiProj::O_MQ == WS_MQ, "EpiProj offsets");

constexpr int RING_OFF = 0, RING_BYTES = 131072;
constexpr int LDSCTL_OFF = RING_BYTES, MISC_OFF = LDSCTL_OFF + 320;
constexpr int LDS_BYTES = 147456;
constexpr int EPI_SCR_OFF = RING_BYTES + 1024;
static_assert(EPI_SCR_OFF + 8192 <= LDS_BYTES, "LDS map");
#define GAS __attribute__((address_space(1)))
#define LAS __attribute__((address_space(3)))
typedef unsigned short bf16;
typedef unsigned v4u __attribute__((ext_vector_type(4)));
typedef float f32x4 __attribute__((ext_vector_type(4)));
typedef short bf16x8 __attribute__((ext_vector_type(8)));
typedef GAS unsigned gu32;
typedef GAS unsigned long long gu64;
#define RLX_AGENT __ATOMIC_RELAXED, __HIP_MEMORY_SCOPE_AGENT
#define LDS_WAIT() asm volatile("s_waitcnt lgkmcnt(0)" ::: "memory")
#define VM_WAIT() asm volatile("s_waitcnt vmcnt(0)" ::: "memory")
__device__ __forceinline__ unsigned long long rt() { return __builtin_amdgcn_s_memrealtime(); }
__device__ __forceinline__ unsigned f2bf(float f) { unsigned u = __builtin_bit_cast(unsigned, f); return (u + 0x7fffu + ((u >> 16) & 1u)) >> 16; }
__device__ __forceinline__ unsigned pk2(float lo, float hi) { return f2bf(lo) | (f2bf(hi) << 16); }

#define XB_TMO      128
#define XB_XCNT(j)  (256  + 64 * (j))
#define XB_XSUB(j)  (1280 + 64 * (j))
#define XB_XGEN(j)  (2304 + 64 * (j))
#define XB_TOP      3328
#define XB_TOPGEN   3392
#define XCD_BAR_WORDS 3456
#define XB_SPIN_CAP (1u << 18)

__device__ __forceinline__ unsigned xb_ld(unsigned* p)              { return __hip_atomic_load(p, __ATOMIC_RELAXED, __HIP_MEMORY_SCOPE_AGENT); }
__device__ __forceinline__ unsigned xb_add(unsigned* p, unsigned v) { return __hip_atomic_fetch_add(p, v, __ATOMIC_RELAXED, __HIP_MEMORY_SCOPE_AGENT); }
__device__ __forceinline__ unsigned xb_xcc_id() { return (unsigned)__builtin_amdgcn_s_getreg((3 << 11) | 20) & 0xFu; }
#define XB_SPIN(cond, bar) do { unsigned _sp = 0; while (cond) { __builtin_amdgcn_s_sleep(1); \
    if ((++_sp & 255u) == 0u) { if (xb_ld(&(bar)[XB_TMO])) break; if (_sp > XB_SPIN_CAP) { atomicAdd(&(bar)[XB_TMO], 1u); break; } } } } while (0)

struct XcdBarrier {
    unsigned* bar; unsigned x; int w0;
    volatile LAS unsigned* st;
};

__device__ __forceinline__ bool xb_t0(int w0) { unsigned z_ = 0u; asm volatile("" : "+v"(z_)); return w0 == 0 && __builtin_amdgcn_mbcnt_hi(~0u, __builtin_amdgcn_mbcnt_lo(~0u, z_)) == 0u; }
__device__ __forceinline__ XcdBarrier xcd_barrier_post(unsigned* bar, volatile LAS unsigned* st, int w0) {
    XcdBarrier b; b.bar = bar; b.x = xb_xcc_id(); b.st = st; b.w0 = w0;
    if (xb_t0(w0)) (void)xb_add(&bar[XB_XCNT(b.x)], 1u);
    return b;
}
__device__ __forceinline__ void xcd_barrier_complete(unsigned* bar, unsigned x, unsigned& nloc, unsigned& nx) {
    const unsigned G = gridDim.x * gridDim.y * gridDim.z;
    unsigned sum, cnt, mine, sp = 0u;
    for (;;) {
        sum = 0u; cnt = 0u; mine = 0u;
#pragma unroll
        for (unsigned j = 0; j < 16; ++j) { const unsigned c = xb_ld(&bar[XB_XCNT(j)]); sum += c; cnt += (c > 0u) ? 1u : 0u; mine = (j == x) ? c : mine; }
        if (sum == G) break;
        __builtin_amdgcn_s_sleep(1);
        if ((++sp & 255u) == 0u) { if (xb_ld(&bar[XB_TMO])) break; if (sp > XB_SPIN_CAP) { atomicAdd(&bar[XB_TMO], 1u); break; } }
    }
    nloc = mine > 0u ? mine : 1u; nx = cnt > 0u ? cnt : 1u;
}

struct XbNoFill { __device__ __forceinline__ void operator()() const {} };
template <class Fill = XbNoFill>
__device__ __forceinline__ void xcd_barrier(const XcdBarrier& b, const Fill& fill = Fill()) {
    asm volatile("s_waitcnt vmcnt(0)" ::: "memory");
    __syncthreads();
    if (xb_t0(b.w0)) {
        unsigned* bar = b.bar;
        __builtin_amdgcn_s_waitcnt(0);
        unsigned nloc = b.st[0], nx = b.st[1];
        if (nloc == 0u) { xcd_barrier_complete(bar, b.x, nloc, nx); b.st[0] = nloc; b.st[1] = nx; }
        const unsigned old = xb_add(&bar[XB_XSUB(b.x)], 1u);
        const unsigned gen = old / nloc;
        if (old + 1u == (gen + 1u) * nloc) {
            __builtin_amdgcn_fence(__ATOMIC_RELEASE, "agent");
            asm volatile("s_waitcnt vmcnt(0)" ::: "memory");
            const unsigned og = xb_add(&bar[XB_TOP], 1u);
            const unsigned tg = og / nx;
            if (og + 1u == (tg + 1u) * nx) xb_add(&bar[XB_TOPGEN], 1u);
            else XB_SPIN(xb_ld(&bar[XB_TOPGEN]) == tg, bar);
            __builtin_amdgcn_fence(__ATOMIC_ACQUIRE, "agent");
            xb_add(&bar[XB_XGEN(b.x)], 1u);
            asm volatile("s_waitcnt vmcnt(0)" ::: "memory");
        } else {
            XB_SPIN(xb_ld(&bar[XB_XGEN(b.x)]) == gen, bar);
            __builtin_amdgcn_fence(__ATOMIC_ACQUIRE, "agent");
            asm volatile("s_waitcnt vmcnt(0)" ::: "memory");
        }
    } else if (b.w0 != 0) { fill(); }
    __syncthreads();
}

#ifndef HG_PROBE
#define HG_PROBE 0
#endif
#ifndef MK_PER_PHASE
#define MK_PER_PHASE 0
#endif
#ifndef DEFER_T_ON
#define DEFER_T_ON 1
#endif
#ifndef DEFER_R_ON
#define DEFER_R_ON 1
#endif
constexpr bool DEFER_T = !MK_PER_PHASE && DEFER_T_ON, DEFER_R = !MK_PER_PHASE && DEFER_R_ON;
struct Args { const float* in[20]; float* out; unsigned char* ws; int ph_lo, ph_hi; };
struct Frame {
    LAS unsigned char* lds;
    volatile LAS unsigned* MISC;
    gu32* ctl;
    int tid, lane, wave, vcu, G;
};
__device__ __forceinline__ float wave_sum(float v) {
#pragma unroll
    for (int o = 1; o < 64; o <<= 1) v += __shfl_xor(v, o);
    return v;
}
__device__ __forceinline__ float wave_max(float v) {
#pragma unroll
    for (int o = 1; o < 64; o <<= 1) v = fmaxf(v, __shfl_xor(v, o));
    return v;
}
__device__ __forceinline__ float bf2f(unsigned short b) { return __builtin_bit_cast(float, (unsigned)b << 16); }
__device__ __forceinline__ float h2f(unsigned short b) { return (float)__builtin_bit_cast(_Float16, b); }
__device__ __forceinline__ float blo(unsigned w) { return __builtin_bit_cast(float, w << 16); }
__device__ __forceinline__ float bhi(unsigned w) { return __builtin_bit_cast(float, w & 0xffff0000u); }

struct P0Item { const float* W; int N; bf16* WT; int ldk, koff, k0, scol0, drow0; const float* ks; float cs; };
__device__ __forceinline__ void p0_item_load(const P0Item& d, float (&wv)[32], int lane) {
#pragma unroll
    for (int i = 0; i < 32; ++i) wv[i] = d.W[(size_t)(d.k0 + 2 * i + (lane >> 5)) * d.N + d.scol0 + (lane & 31)];
}
__device__ __forceinline__ void p0_item_finish(const P0Item& d, const float (&wv)[32], LAS float* scr, int lane) {
#pragma unroll
    for (int i = 0; i < 32; ++i) { const int kk = 2 * i + (lane >> 5); float v = wv[i] * d.cs; if (d.ks) v *= d.ks[d.k0 + kk]; scr[kk * 33 + (lane & 31)] = v; }
    LDS_WAIT(); asm volatile("" ::: "memory");
    const int c = lane & 7;
#pragma unroll
    for (int j = 0; j < 4; ++j) { const int n = (lane >> 3) + 8 * j; const LAS float* s = scr + (8 * c) * 33 + n;
        v4u o; o.x = pk2(s[0 * 33], s[1 * 33]); o.y = pk2(s[2 * 33], s[3 * 33]); o.z = pk2(s[4 * 33], s[5 * 33]); o.w = pk2(s[6 * 33], s[7 * 33]);
        *(GAS v4u*)(d.WT + (size_t)(d.drow0 + n) * d.ldk + d.koff + d.k0 + 8 * c) = o; }
    LDS_WAIT(); asm volatile("" ::: "memory");
}
__device__ __forceinline__ void p0_transpose_item(const float* W, int N, bf16* WT, int ldk, int koff, int k0, int scol0, int drow0, const float* ks, LAS float* scr, int lane) {
    const P0Item d{W, N, WT, ldk, koff, k0, scol0, drow0, ks, 1.0f}; float wv[32]; p0_item_load(d, wv, lane); p0_item_finish(d, wv, scr, lane);
}
__device__ __forceinline__ void p0_plain(const float* W, int K, int N, bf16* WT, int ldk, int koff, int item, LAS float* scr, int lane) {
    const int nblk = N / 32, kb = item / nblk, nb = item % nblk;
    p0_transpose_item(W, N, WT, ldk, koff, 64 * kb, 32 * nb, 32 * nb, nullptr, scr, lane);
}
__device__ __forceinline__ void rms_rows4_to_bf16(const float* x, const float* gain, bf16* o, int m0, int rstride, int lane) {
    f32x4 v[4][4]; float s[4];
#pragma unroll
    for (int r = 0; r < 4; ++r) { const GAS f32x4* xr = (const GAS f32x4*)(x + (size_t)(m0 + r * rstride) * D) + lane;
#pragma unroll
        for (int j = 0; j < 4; ++j) v[r][j] = xr[64 * j]; }
    f32x4 g[4];
#pragma unroll
    for (int j = 0; j < 4; ++j) g[j] = ((const GAS f32x4*)gain + lane)[64 * j];
#pragma unroll
    for (int r = 0; r < 4; ++r) { float t = 0.f;
#pragma unroll
        for (int j = 0; j < 4; ++j) t += (v[r][j].x * v[r][j].x + v[r][j].y * v[r][j].y) + (v[r][j].z * v[r][j].z + v[r][j].w * v[r][j].w);
        s[r] = 1.0f / sqrtf(wave_sum(t) * (1.f / 1024.f) + RMS_EPS); }
#pragma unroll
    for (int r = 0; r < 4; ++r) { GAS unsigned long long* o8 = (GAS unsigned long long*)(o + (size_t)(m0 + r * rstride) * D) + lane;
#pragma unroll
        for (int j = 0; j < 4; ++j) o8[64 * j] = (unsigned long long)pk2(v[r][j].x * s[r] * g[j].x, v[r][j].y * s[r] * g[j].y) | ((unsigned long long)pk2(v[r][j].z * s[r] * g[j].z, v[r][j].w * s[r] * g[j].w) << 32); }
}
template <int NR> __device__ __forceinline__ void rmsN_load(const float* x, int m0, f32x4 (&v)[NR][4], int lane) {
#pragma unroll
    for (int r = 0; r < NR; ++r) { const GAS f32x4* xr = (const GAS f32x4*)(x + (size_t)(m0 + r) * D) + lane;
#pragma unroll
        for (int j = 0; j < 4; ++j) v[r][j] = xr[64 * j]; }
}
template <int NR> __device__ __forceinline__ void rmsN_finish(const f32x4 (&v)[NR][4], const f32x4 (&g)[4], bf16* o, int m0, int lane) {
    float s[NR];
#pragma unroll
    for (int r = 0; r < NR; ++r) { float t = 0.f;
#pragma unroll
        for (int j = 0; j < 4; ++j) t += (v[r][j].x * v[r][j].x + v[r][j].y * v[r][j].y) + (v[r][j].z * v[r][j].z + v[r][j].w * v[r][j].w);
        s[r] = 1.0f / sqrtf(wave_sum(t) * (1.f / 1024.f) + RMS_EPS); }
#pragma unroll
    for (int r = 0; r < NR; ++r) { GAS unsigned long long* o8 = (GAS unsigned long long*)(o + (size_t)(m0 + r) * D) + lane;
#pragma unroll
        for (int j = 0; j < 4; ++j) o8[64 * j] = (unsigned long long)pk2(v[r][j].x * s[r] * g[j].x, v[r][j].y * s[r] * g[j].y) | ((unsigned long long)pk2(v[r][j].z * s[r] * g[j].z, v[r][j].w * s[r] * g[j].w) << 32); }
}
__device__ __forceinline__ void p0_prologue(Frame& F, const Args& A) {
    LAS float* scr = (LAS float*)(F.lds + RING_OFF + F.wave * 16384);
    const int gw = F.vcu * NWAVES + F.wave, NGW = F.G * NWAVES;
    bf16* WIN = (bf16*)(A.ws + WS_WIN); bf16* WFI = (bf16*)(A.ws + WS_WFI); bf16* WFO = (bf16*)(A.ws + WS_WFO); bf16* WPC = (bf16*)(A.ws + WS_WPC); bf16* WO = (bf16*)(A.ws + WS_WO); bf16* WKV = (bf16*)(A.ws + WS_WKV);
    constexpr int I_IN = 16 * (INC / 32), I_FI = 16 * (2 * DFF / 32), I_FO = (DFF / 64) * 32, I_PH = 16 * 32, I_PD = 8 * 32, I_PM = 8 * 32, I_O = 16 * 32, I_KV = 16 * 32;
    constexpr int NITEMS = I_IN + I_FI + I_FO + I_PH + I_PD + I_PM + I_O + I_KV;
    auto desc = [&](int it, P0Item& d) -> bool {
        int r = it;
        if (DEFER_T) { if (r >= I_IN) r += I_FI + I_FO; if (r >= I_IN + I_FI + I_FO + I_PH + I_PD + I_PM) r += I_O; }
        auto plain = [&](const float* W, int K, int N, bf16* WT, int ldk, int koff, int item) { const int nblk = N / 32, kb = item / nblk, nb = item % nblk; (void)K; d = P0Item{W, N, WT, ldk, koff, 64 * kb, 32 * nb, 32 * nb, nullptr, 1.0f}; };
        if (r < I_IN) { plain(A.in[4], 1024, INC, WIN, 1024, 0, r);
            const int n0 = d.scol0; if (n0 < 3072 || (n0 >= 4096 && n0 < 5120) || n0 >= 10240) d.cs = -1.4426950408889634f; return true; } r -= I_IN;
        if (r < I_FI) { if (DEFER_T) return false;
            const int nblk = 2 * DFF / 32, kb = r / nblk, nb = r % nblk, d0 = 32 * nb, tile = d0 >> 8, within = d0 & 255;
            const int sc = within < 128 ? 128 * tile + within : DFF + 128 * tile + (within - 128);
            d = P0Item{A.in[18], 2 * DFF, WFI, 1024, 0, 64 * kb, sc, d0, A.in[17], 1.0f}; return true; } r -= I_FI;
        if (r < I_FO) { if (DEFER_T) return false; plain(A.in[19], DFF, 1024, WFO, DFF, 0, r); return true; } r -= I_FO;
        if (r < I_PH) { plain(A.in[13], 1024, 1024, WPC, 2048, 0, r); return true; } r -= I_PH;
        if (r < I_PD) { plain(A.in[14], 512, 1024, WPC, 2048, 1024, r); return true; } r -= I_PD;
        if (r < I_PM) { plain(A.in[15], 512, 1024, WPC, 2048, 1536, r); return true; } r -= I_PM;
        if (r < I_O) { if (DEFER_T) return false; plain(A.in[16], 1024, 1024, WO, 1024, 0, r); return true; } r -= I_O;
        plain(A.in[10], 1024, 1024, WKV, 1024, 0, r); return true; };
    bf16* H = (bf16*)(A.ws + WS_H); bf16* MEMN = (bf16*)(A.ws + WS_MEMN);
    constexpr int NR = DEFER_R ? 3 : 4; const int Q = (DEFER_R ? GR + 2048 : MTOK) / NR;
    static_assert((GR + 2048) % 3 == 0 && MTOK % 4 == 0, "row steps");
    f32x4 vm[1][4], vA[NR][4], vB[NR][4]; int q = gw, qA = 0, qB = 0;
    if (gw < BATCH * NMEM) rmsN_load<1>(A.in[1], gw, vm, F.lane);
    const bool hrow0 = q < Q; if (hrow0) { qA = q; q += NGW; rmsN_load<NR>(A.in[0], NR * qA, vA, F.lane); }
    { int it = gw; P0Item dA, dB; float wA[32], wB[32]; bool hA = false, hB = false;
#define P0_NEXT(H_, D_, W_) do { H_ = false; while (it < (DEFER_T ? NITEMS - I_FI - I_FO - I_O : NITEMS)) { const bool ok_ = desc(it, D_); it += NGW; if (ok_) { H_ = true; break; } } if (H_) p0_item_load(D_, W_, F.lane); } while (0)
        P0_NEXT(hA, dA, wA);
        while (hA) {
            P0_NEXT(hB, dB, wB);
            p0_item_finish(dA, wA, scr, F.lane);
            if (!hB) break;
            P0_NEXT(hA, dA, wA);
            p0_item_finish(dB, wB, scr, F.lane);
        }
#undef P0_NEXT
    }
    { f32x4 g4[4];
#pragma unroll
        for (int j = 0; j < 4; ++j) g4[j] = ((const GAS f32x4*)A.in[2] + F.lane)[64 * j];
        if (hrow0) {
            for (;;) { const bool hB = q < Q; if (hB) { qB = q; q += NGW; rmsN_load<NR>(A.in[0], NR * qB, vB, F.lane); }
                rmsN_finish<NR>(vA, g4, H, NR * qA, F.lane); if (!hB) break;
                const bool hA = q < Q; if (hA) { qA = q; q += NGW; rmsN_load<NR>(A.in[0], NR * qA, vA, F.lane); }
                rmsN_finish<NR>(vB, g4, H, NR * qB, F.lane); if (!hA) break; } }
#pragma unroll
        for (int j = 0; j < 4; ++j) g4[j] = ((const GAS f32x4*)A.in[3] + F.lane)[64 * j];
        if (gw < BATCH * NMEM) rmsN_finish<1>(vm, g4, MEMN, gw, F.lane);
        for (int m = gw + NGW; m < BATCH * NMEM; m += NGW) { rmsN_load<1>(A.in[1], m, vm, F.lane); rmsN_finish<1>(vm, g4, MEMN, m, F.lane); } }
    float* LB = (float*)(A.ws + WS_LB);
    for (int i = gw * 64 + F.lane; i < 2048; i += NGW * 64) { const float* lg = (i < 1024) ? A.in[5] : A.in[6]; const int c = i & 1023; LB[i] = 1.0f / (1.0f + __expf(lg[1024 + c] - lg[c])); }
}


constexpr int DF_IO = 16 * 32, DF_IFI = 16 * (2 * DFF / 32), DF_IFO = (DFF / 64) * 32, DF_NT = DF_IO + DF_IFI + DF_IFO;
__device__ __forceinline__ void p0_deferred_item(const Args& A, int t, LAS float* scr, int lane) {
    bf16* WFI = (bf16*)(A.ws + WS_WFI); bf16* WFO = (bf16*)(A.ws + WS_WFO); bf16* WO = (bf16*)(A.ws + WS_WO);
    if (t < DF_IO) { p0_plain(A.in[16], 1024, 1024, WO, 1024, 0, t, scr, lane); return; } t -= DF_IO;
    if (t < DF_IFI) { const int nblk = 2 * DFF / 32, kb = t / nblk, nb = t % nblk, d0 = 32 * nb, tile = d0 >> 8, within = d0 & 255;
        const int sc = within < 128 ? 128 * tile + within : DFF + 128 * tile + (within - 128);
        p0_transpose_item(A.in[18], 2 * DFF, WFI, 1024, 0, 64 * kb, sc, d0, A.in[17], scr, lane); return; } t -= DF_IFI;
    p0_plain(A.in[19], DFF, 1024, WFO, DFF, 0, t, scr, lane);
}
struct DeferFill { int seam, wave, lane, vcu, G; LAS unsigned char* lds;
    __device__ __forceinline__ void operator()() const {
        if (MK_PER_PHASE) return;
#if defined(__HIP_DEVICE_COMPILE__)
        Args A; { const __attribute__((address_space(4))) Args* ap_ = (const __attribute__((address_space(4))) Args*)__builtin_amdgcn_kernarg_segment_ptr(); asm volatile("" : "+s"(ap_)); A = *ap_; }
        const int wi = vcu * 7 + (wave - 1), NW = G * 7;
        if (seam == 1 || seam == 2) { if (!DEFER_R) return;
            bf16* H = (bf16*)(A.ws + WS_H); const int per = (4096 - 512 + 1) / 2;
            for (int q = 512 + (seam - 1) * per + wi; q < 512 + seam * per && q < 4096; q += NW) rms_rows4_to_bf16(A.in[0], A.in[2], H, GR + 4 * q, 1, lane);
        } else { const int part = seam == 3 ? 0 : seam - 4;
            if (part < 0 || part > 5) return;
            LAS float* scr = (LAS float*)(lds + RING_OFF + wave * 16384);
            const int lo = part * (DF_NT / 6), hi = part == 5 ? DF_NT : (part + 1) * (DF_NT / 6);
            if (DEFER_T) for (int t = lo + wi; t < hi; t += NW) p0_deferred_item(A, t, scr, lane);
            if ((seam == 3 || seam == 7) && wave <= 6) {
                pg8::StaticOrder S; S.init(GR, 1024, G, (int)blockIdx.x); pg8::Unit u;
                if (S.next(0, u)) { const unsigned char* gp = (const unsigned char*)A.out + OUT_GATES + (size_t)(seam == 7 ? 1 : 0) * (48u << 20) + ((size_t)(((wave - 1) >> 1) * 64 + u.pm) * 4 + u.pn) * 65536 + ((wave - 1) & 1) * 32768 + lane * 16;
                    unsigned acc = 0u;
#pragma unroll 8
                    for (int i = 0; i < 32; ++i) { const v4u v = *(const v4u*)(gp + i * 1024); acc += (v.x ^ v.y) + (v.z ^ v.w); }
                    if (acc == 0x9e3779b9u) ((unsigned*)(A.ws + WS_CTL))[2048 + lane] = acc; } } }
#endif
    } };

struct RotOrder : pg8::StaticOrder {
    __device__ __forceinline__ bool next(int i, pg8::Unit& u) const { const bool ok = pg8::StaticOrder::next(i, u); if (ok) { u.pn += 40; if (u.pn >= 52) u.pn -= 52; } return ok; }
};
struct RevOrder : pg8::StaticOrder {
    __device__ __forceinline__ bool next(int i, pg8::Unit& u) const { const int n = (nwg - c + G - 1) / G; if (i >= n) return false; return pg8::StaticOrder::next(n - 1 - i, u); }
};
namespace att {
using bf16x8 = __attribute__((ext_vector_type(8))) short;
using s16x4  = __attribute__((ext_vector_type(4))) short;
using f32x16 = __attribute__((ext_vector_type(16))) float;
using u32x4  = __attribute__((ext_vector_type(4))) unsigned;
#define KSWZ(row, colB) ((row) * 256 + ((colB) ^ (((row) & 7) << 4)))
#define SBAR() __builtin_amdgcn_sched_barrier(0)
__device__ __forceinline__ int crow(int r, int hi) { return (r & 3) + 8 * (r >> 2) + 4 * hi; }
__device__ __forceinline__ unsigned cvtpk(float lo, float hi) { unsigned r; asm volatile("v_cvt_pk_bf16_f32 %0, %1, %2" : "=v"(r) : "v"(lo), "v"(hi)); return r; }
constexpr int SHM_K = 64 * 128 * 2, SHM_V = 64 * 128 * 2;
constexpr int OFF_V = 0, OFF_K = 2 * SHM_V, OFF_WS = 2 * SHM_V + 2 * SHM_K;
__device__ __forceinline__ void qkt(f32x16& p0, f32x16& p1, const char* Ks, const bf16x8* qr, int r32, int hi) {
  p0 = f32x16{}; p1 = f32x16{};
#pragma unroll
  for (int d0 = 0; d0 < 8; ++d0) { const int cb = (d0 * 16 + hi * 8) * 2;
    const bf16x8 b0 = *reinterpret_cast<const bf16x8*>(Ks + KSWZ(r32, cb));
    const bf16x8 b1 = *reinterpret_cast<const bf16x8*>(Ks + KSWZ(32 + r32, cb));
    p0 = __builtin_amdgcn_mfma_f32_32x32x16_bf16(b0, qr[d0], p0, 0, 0, 0);
    p1 = __builtin_amdgcn_mfma_f32_32x32x16_bf16(b1, qr[d0], p1, 0, 0, 0); }
}
__device__ __forceinline__ int v_st(int k, int c) { const int kk = (k & ~0xC) | ((k & 4) << 1) | ((k & 8) >> 1); return ((kk >> 3) * 4 + (c >> 5)) * 512 + ((kk & 7) * 32 + (c & 31)) * 2; }
__device__ __forceinline__ int v_rd_base(int lane) { return ((lane & 3) << 3) | (((lane >> 2) & 3) << 6) | (((lane >> 4) & 1) << 5) | (((lane >> 5) & 1) << 8); }
constexpr int v_rd_off(int d0, int ks, int half) { return d0 * 512 + ks * 4096 + half * 2048; }
template <int OFF> __device__ __forceinline__ s16x4 tr_read(int vb) { s16x4 r; asm volatile("ds_read_b64_tr_b16 %0, %1 offset:%2" : "=&v"(r) : "v"(vb), "i"(OFF) : "memory"); return r; }
template <int D0> __device__ __forceinline__ void pv_one(f32x16& od, int vb, bf16x8 pa0, bf16x8 pa1, bf16x8 pa2, bf16x8 pa3) {
  const s16x4 l0 = tr_read<v_rd_off(D0, 0, 0)>(vb), h0 = tr_read<v_rd_off(D0, 0, 1)>(vb), l1 = tr_read<v_rd_off(D0, 1, 0)>(vb), h1 = tr_read<v_rd_off(D0, 1, 1)>(vb);
  const s16x4 l2 = tr_read<v_rd_off(D0, 2, 0)>(vb), h2 = tr_read<v_rd_off(D0, 2, 1)>(vb), l3 = tr_read<v_rd_off(D0, 3, 0)>(vb), h3 = tr_read<v_rd_off(D0, 3, 1)>(vb);
  asm volatile("s_waitcnt lgkmcnt(0)" ::: "memory"); SBAR();
#define PK(L, H) (bf16x8){L[0], L[1], L[2], L[3], H[0], H[1], H[2], H[3]}
  od = __builtin_amdgcn_mfma_f32_32x32x16_bf16(pa0, PK(l0, h0), od, 0, 0, 0);
  od = __builtin_amdgcn_mfma_f32_32x32x16_bf16(pa1, PK(l1, h1), od, 0, 0, 0);
  od = __builtin_amdgcn_mfma_f32_32x32x16_bf16(pa2, PK(l2, h2), od, 0, 0, 0);
  od = __builtin_amdgcn_mfma_f32_32x32x16_bf16(pa3, PK(l3, h3), od, 0, 0, 0);
#undef PK
}
__device__ __forceinline__ void attn_unit(const bf16* Qb, long QS, const bf16* Kb, const bf16* Vb, long KS, int ntile, int tile0, int Ld, int n0, bool band, float slope2,
                                          bf16* Ob, long OS, float* lsep, long LS, LAS unsigned char* ldsb, int tid, unsigned long long* PRB) {
  const int wid = __builtin_amdgcn_readfirstlane(tid >> 6), lane = tid & 63, r32 = lane & 31, hi = lane >> 5;
#define AT_T(var) unsigned long long var = 0; if (HG_PROBE) var = __builtin_amdgcn_s_memrealtime()
#define AT_ACC(slot, a_, b_) do { if (HG_PROBE && blockIdx.x == 0 && wid == 0 && lane == 0) PRB[slot] += (b_) - (a_); } while (0)
  AT_T(ta0);
  char* lds = (char*)ldsb;
  char* V_lds = lds + OFF_V; char* K_lds = lds + OFF_K;
  float* wsf = (float*)(lds + OFF_WS) + wid * 64; float* li_l = wsf; float* al_l = wsf + 32;
  float m_reg = -1e30f, l_reg = 0.f; f32x16 o[4] = {}; bf16x8 qr[8];
  const bf16* Qw = Qb + (long)(wid * 32 + r32) * QS + hi * 8;
#pragma unroll
  for (int d0 = 0; d0 < 8; ++d0) qr[d0] = *reinterpret_cast<const bf16x8*>(Qw + d0 * 16);
  const int sr = tid >> 4, sc = (tid & 15) * 8, vst0 = v_st(sr, sc), vst1 = v_st(32 + sr, sc);
  const int vb0 = (int)(uintptr_t)V_lds + v_rd_base(lane);
  int t_lo = 0, t_hi = ntile;
  while (t_lo < t_hi && (tile0 + 64 * t_lo) < 0) ++t_lo;
  while (t_hi > t_lo && (tile0 + 64 * (t_hi - 1)) >= Ld) --t_hi;
  bf16x8 vs0, vs1, ks0, ks1;
#define SLOAD(tau) do { const long k0_ = (long)(tile0 + 64 * (tau)); vs0 = *reinterpret_cast<const bf16x8*>(Vb + (k0_ + sr) * KS + sc); vs1 = *reinterpret_cast<const bf16x8*>(Vb + (k0_ + 32 + sr) * KS + sc); \
    ks0 = *reinterpret_cast<const bf16x8*>(Kb + (k0_ + sr) * KS + sc); ks1 = *reinterpret_cast<const bf16x8*>(Kb + (k0_ + 32 + sr) * KS + sc); } while (0)
#define SWRITE(b) do { *(bf16x8*)(V_lds + (b) * SHM_V + vst0) = vs0; *(bf16x8*)(V_lds + (b) * SHM_V + vst1) = vs1; const int kc_ = sc * 2; \
    *(bf16x8*)(K_lds + (b) * SHM_K + KSWZ(sr, kc_)) = ks0; *(bf16x8*)(K_lds + (b) * SHM_K + KSWZ(32 + sr, kc_)) = ks1; } while (0)
  SLOAD(t_lo); SWRITE(0); __syncthreads();
  AT_T(ta1); AT_ACC(8, ta0, ta1);
  const int w_lo = wid >> 1;
  for (int tau = t_lo; tau < t_hi; ++tau) {
    const int buf = (tau - t_lo) & 1;
    if (tau + 1 < t_hi) SLOAD(tau + 1);
    const bool active = !band || (tau >= w_lo && tau <= w_lo + 2);
    if (active) {
      f32x16 p0, p1;
      qkt(p0, p1, K_lds + buf * SHM_K, qr, r32, hi);
      if (band) { const int rel0 = (tile0 + 64 * tau) - (n0 + wid * 32 + r32);
#pragma unroll
        for (int r = 0; r < 16; ++r) { const int ra = rel0 + crow(r, hi), rb = ra + 32; const int aa = ra < 0 ? -ra : ra, ab = rb < 0 ? -rb : rb;
          p0[r] = aa <= 64 ? p0[r] - slope2 * (float)aa : -2e30f; p1[r] = ab <= 64 ? p1[r] - slope2 * (float)ab : -2e30f; } }
      float pmax = p0[0];
#pragma unroll
      for (int r = 1; r < 16; ++r) pmax = fmaxf(pmax, p0[r]);
#pragma unroll
      for (int r = 0; r < 16; ++r) pmax = fmaxf(pmax, p1[r]);
      { auto rr = __builtin_amdgcn_permlane32_swap(__float_as_uint(pmax), __float_as_uint(pmax), false, false); pmax = fmaxf(__uint_as_float(rr[0]), __uint_as_float(rr[1])); }
      const float mn = fmaxf(m_reg, pmax), alpha = __builtin_amdgcn_exp2f(m_reg - mn); m_reg = mn;
      float ps;
      { p0 = p0 - mn; p1 = p1 - mn;
#pragma unroll
        for (int r = 0; r < 16; ++r) { p0[r] = __builtin_amdgcn_exp2f(p0[r]); p1[r] = __builtin_amdgcn_exp2f(p1[r]); }
        const f32x16 t = p0 + p1; ps = (((t[0] + t[1]) + (t[2] + t[3])) + ((t[4] + t[5]) + (t[6] + t[7]))) + (((t[8] + t[9]) + (t[10] + t[11])) + ((t[12] + t[13]) + (t[14] + t[15]))); }
      { auto rr = __builtin_amdgcn_permlane32_swap(__float_as_uint(ps), __float_as_uint(ps), false, false); ps = __uint_as_float(rr[0]) + __uint_as_float(rr[1]); }
      l_reg = l_reg * alpha + ps;
      if (__any(alpha < 1.f)) { if (hi == 0) al_l[r32] = alpha; asm volatile("s_waitcnt lgkmcnt(0)" ::: "memory");
#pragma unroll
        for (int d = 0; d < 4; ++d)
#pragma unroll
          for (int r = 0; r < 16; ++r) o[d][r] *= al_l[crow(r, hi)]; }
      bf16x8 pa0, pa1, pa2, pa3;
#define PK4(P, BASE, OUT) do { unsigned a0 = cvtpk(P[BASE + 0], P[BASE + 1]), a1 = cvtpk(P[BASE + 2], P[BASE + 3]);   \
    unsigned b0 = cvtpk(P[BASE + 4], P[BASE + 5]), b1 = cvtpk(P[BASE + 6], P[BASE + 7]);                              \
    auto r0 = __builtin_amdgcn_permlane32_swap(a0, b0, false, false); auto r1 = __builtin_amdgcn_permlane32_swap(a1, b1, false, false); \
    u32x4 w = {r0[0], r1[0], r0[1], r1[1]}; OUT = *reinterpret_cast<bf16x8*>(&w); } while (0)
      PK4(p0, 0, pa0); PK4(p0, 8, pa1); PK4(p1, 0, pa2); PK4(p1, 8, pa3);
#undef PK4
      const int vb = vb0 + buf * SHM_V;
      pv_one<0>(o[0], vb, pa0, pa1, pa2, pa3); pv_one<1>(o[1], vb, pa0, pa1, pa2, pa3); pv_one<2>(o[2], vb, pa0, pa1, pa2, pa3); pv_one<3>(o[3], vb, pa0, pa1, pa2, pa3);
    }
    if (tau + 1 < t_hi) SWRITE(buf ^ 1);
    __syncthreads();
  }
  AT_T(ta2); AT_ACC(9, ta1, ta2);
  if (hi == 0) li_l[r32] = l_reg; asm volatile("s_waitcnt lgkmcnt(0)" ::: "memory");
  if (lsep && hi == 0) lsep[(long)(wid * 32 + r32) * LS] = m_reg + __log2f(l_reg);
  float rli[16];
#pragma unroll
  for (int r = 0; r < 16; ++r) rli[r] = __builtin_amdgcn_rcpf(li_l[crow(r, hi)]);
  bf16* Ow = Ob + (long)(wid * 32) * OS;
#pragma unroll
  for (int r = 0; r < 16; ++r) { const int orow = crow(r, hi);
#pragma unroll
    for (int d0 = 0; d0 < 4; ++d0) Ow[(long)orow * OS + d0 * 32 + r32] = (bf16)f2bf(o[d0][r] * rli[r]); }
  __syncthreads();
  AT_T(ta3); AT_ACC(10, ta2, ta3);
#undef SLOAD
#undef SWRITE
}
#undef KSWZ
#undef SBAR
}


namespace hg {
using bf16x8 = __attribute__((ext_vector_type(8))) short;
using f32x16 = __attribute__((ext_vector_type(16))) float;
using u32x4  = __attribute__((ext_vector_type(4))) unsigned;
using u32x2  = __attribute__((ext_vector_type(2))) unsigned;
typedef short v4i16_t __attribute__((ext_vector_type(4)));
constexpr int L_QIN = 0, L_KIN = 16384, L_V = 16384 + 18432, L_DEC = L_V + 20480, L_DIRBYTES = 65536;
constexpr int L_SSQ = L_DEC + 512;
constexpr int L_CNT = 2 * L_DIRBYTES - 64;
static_assert(L_SSQ + 1024 <= L_DIRBYTES - 64, "hgrn LDS map");
__device__ __forceinline__ int crow(int r, int hi) { return (r & 3) + 8 * (r >> 2) + 4 * hi; }
typedef float f32x2_t __attribute__((ext_vector_type(2))); typedef __bf16 bf16x2_t __attribute__((ext_vector_type(2)));
__device__ __forceinline__ unsigned cvtpk(float lo, float hi) { const f32x2_t v = {lo, hi}; const bf16x2_t b = __builtin_convertvector(v, bf16x2_t); return __builtin_bit_cast(unsigned, b); }
__device__ __forceinline__ bf16x8 trfrag(const LAS unsigned char* lo, const LAS unsigned char* hi) {
  const v4i16_t a = __builtin_amdgcn_ds_read_tr16_b64_v4i16((LAS v4i16_t*)lo), b = __builtin_amdgcn_ds_read_tr16_b64_v4i16((LAS v4i16_t*)hi);
  return (bf16x8){a[0], a[1], a[2], a[3], b[0], b[1], b[2], b[3]};
}
__device__ __forceinline__ bf16x8 accfrag(const f32x16& x, int s2) {
  u32x4 w; const int b = 8 * s2; w.x = cvtpk(x[b + 0], x[b + 1]); w.y = cvtpk(x[b + 2], x[b + 3]); w.z = cvtpk(x[b + 4], x[b + 5]); w.w = cvtpk(x[b + 6], x[b + 7]); return __builtin_bit_cast(bf16x8, w);
}
__device__ __forceinline__ void swz_pack(const u32x2 (&w)[4], u32x4& c0, u32x4& c1) {
  const auto rx02 = __builtin_amdgcn_permlane32_swap(w[0].x, w[2].x, false, false), ry02 = __builtin_amdgcn_permlane32_swap(w[0].y, w[2].y, false, false);
  const auto rx13 = __builtin_amdgcn_permlane32_swap(w[1].x, w[3].x, false, false), ry13 = __builtin_amdgcn_permlane32_swap(w[1].y, w[3].y, false, false);
  c0 = (u32x4){rx02[0], ry02[0], rx02[1], ry02[1]}; c1 = (u32x4){rx13[0], ry13[0], rx13[1], ry13[1]};
}
__device__ __forceinline__ void swz_unpack(const u32x4& c0, const u32x4& c1, u32x2 (&w)[4]) {
  const auto rx02 = __builtin_amdgcn_permlane32_swap(c0.x, c0.z, false, false), ry02 = __builtin_amdgcn_permlane32_swap(c0.y, c0.w, false, false);
  const auto rx13 = __builtin_amdgcn_permlane32_swap(c1.x, c1.z, false, false), ry13 = __builtin_amdgcn_permlane32_swap(c1.y, c1.w, false, false);
  w[0] = (u32x2){rx02[0], ry02[0]}; w[2] = (u32x2){rx02[1], ry02[1]}; w[1] = (u32x2){rx13[0], ry13[0]}; w[3] = (u32x2){rx13[1], ry13[1]};
}
__device__ __forceinline__ void dir_bar(LAS unsigned* cnt, unsigned& target, int lane) {
  asm volatile("s_waitcnt lgkmcnt(0)" ::: "memory");
  if (lane == 0) __hip_atomic_fetch_add(cnt, 1u, __ATOMIC_RELAXED, __HIP_MEMORY_SCOPE_WORKGROUP);
  target += 4u;
  while ((int)(__hip_atomic_load(cnt, __ATOMIC_RELAXED, __HIP_MEMORY_SCOPE_WORKGROUP) - target) < 0) __builtin_amdgcn_s_sleep(0);
  asm volatile("" ::: "memory");
}
#ifndef HG_PROBE
#define HG_PROBE 0
#endif
#define HG_T(var) unsigned long long var = 0; if (HG_PROBE) var = __builtin_amdgcn_s_memrealtime()
#define HG_ACC(slot, t0_, t1_) do { if (HG_PROBE && FULL && blockIdx.x == 0 && wave == 0 && lane == 0) PRB[slot] += (t1_) - (t0_); } while (0)
template <bool FULL>
__device__ __forceinline__ void hgrn_item(const bf16* Q, const bf16* V, bf16* LFf, bf16* LFb, const bf16* GG, const float* GAIN, bf16* OC, float* SL, float* DT, int sbh, int sj, LAS unsigned char* ldsb, int tid, unsigned long long* PRB) {
  const int wave = __builtin_amdgcn_readfirstlane(tid >> 6), lane = tid & 63, dir = wave >> 2, dw = wave & 3;
  LAS unsigned char* L = ldsb + dir * L_DIRBYTES;
  bf16* LF = dir ? LFb : LFf; const int stream = sbh * 2 + dir;
  LAS unsigned* cnt = (LAS unsigned*)(ldsb + L_CNT) + dir;
  if (tid < 2) ((LAS unsigned*)(ldsb + L_CNT))[tid] = 0u;
  __syncthreads();
  unsigned target = 0u;
#define LANE_E() int ln_ = lane; asm volatile("" : "+v"(ln_)); const int ig = ln_ >> 4, tq = ln_ & 15, i0 = 32 * dw + 8 * ig
#define LANE_M() int ln_ = lane; asm volatile("" : "+v"(ln_)); const int h = ln_ >> 5, r32 = ln_ & 31, jrow = (ln_ & 15) >> 2, c4 = 16 * ((ln_ >> 4) & 1) + 4 * (ln_ & 3); \
  const int qbase0 = (4 * h + jrow) * 128 + ((((jrow >> 1) & 1)) << 6) + c4 * 2, kbase = (4 * h + jrow) * 144 + c4 * 2, vpbase = (4 * h + jrow) * 320 + (32 * dw + c4) * 2, \
            vnbase = (8 * h + jrow) * 320 + (32 * dw + c4) * 2, knbase = r32 * 144 + 16 * h
  f32x16 S[4];
#pragma unroll
  for (int ib = 0; ib < 4; ++ib) S[ib] = f32x16{};
  HG_T(tp0);
  if (FULL) { LANE_M();
    const int nprev = dir ? 7 - sj : sj;
    for (int idx = 64 * dw + lane; idx < nprev * 128; idx += 256) { const int p = idx >> 7, sp = dir ? 7 - p : p; ((LAS float*)(L + L_QIN))[idx] = DT[((size_t)stream * 8 + sp) * 128 + (idx & 127)]; }
    dir_bar(cnt, target, lane);
    u32x4 a0[8], a1[8];
#define HG_PLOAD(A_, P_) do { const int sp_ = dir ? 7 - (P_) : (P_); const bf16* sl_ = (const bf16*)SL + ((((size_t)stream * 8 + sp_) * 4 + dw) * 4) * 1024 + lane * 16; \
      _Pragma("unroll") for (int ib = 0; ib < 4; ++ib) { A_[2 * ib] = *(const u32x4*)(sl_ + ib * 1024); A_[2 * ib + 1] = *(const u32x4*)(sl_ + ib * 1024 + 8); } } while (0)
#define HG_PFMA(A_, P_) do { _Pragma("unroll") for (int ib = 0; ib < 4; ++ib) _Pragma("unroll") for (int g4 = 0; g4 < 4; ++g4) { const f32x4 d_ = *(const LAS f32x4*)(L + L_QIN + ((P_) * 128 + 32 * ib + 8 * g4 + 4 * h) * 4); \
      const u32x4 w_ = A_[2 * ib + (g4 >> 1)]; const unsigned wl_ = (g4 & 1) ? w_.z : w_.x, wh_ = (g4 & 1) ? w_.w : w_.y; \
      S[ib][4 * g4] = S[ib][4 * g4] * d_[0] + blo(wl_); S[ib][4 * g4 + 1] = S[ib][4 * g4 + 1] * d_[1] + bhi(wl_); S[ib][4 * g4 + 2] = S[ib][4 * g4 + 2] * d_[2] + blo(wh_); S[ib][4 * g4 + 3] = S[ib][4 * g4 + 3] * d_[3] + bhi(wh_); } } while (0)
    if (nprev > 0) HG_PLOAD(a0, 0);
    for (int p = 0; p < nprev; p += 2) {
      if (p + 1 < nprev) HG_PLOAD(a1, p + 1);
      HG_PFMA(a0, p);
      if (p + 1 < nprev) { if (p + 2 < nprev) HG_PLOAD(a0, p + 2); HG_PFMA(a1, p + 1); }
    }
#undef HG_PLOAD
#undef HG_PFMA
    dir_bar(cnt, target, lane);
  }
  HG_T(tp1); HG_ACC(5, tp0, tp1);
  float sumbl[8];
#pragma unroll
  for (int e = 0; e < 8; ++e) sumbl[e] = 0.f;
  u32x4 v8[4], q8[4], f8[4];
#define HG_LOAD(T0) do { LANE_E(); const int dtid_ = 64 * dw + ln_; \
    _Pragma("unroll") for (int u = 0; u < 4; ++u) { const int p = dtid_ + 256 * u, tau = p >> 4, t = (T0) + (dir ? 63 - tau : tau); v8[u] = *(const u32x4*)(V + (unsigned)(t * 1024 + 8 * (p & 15))); } \
    _Pragma("unroll") for (int u = 0; u < 4; ++u) { const int tau = 4 * tq + u, t = (T0) + (dir ? 63 - tau : tau); const unsigned off = (unsigned)(t * 1024 + i0); \
      f8[u] = *(const u32x4*)(LF + off); if (FULL) q8[u] = *(const u32x4*)(Q + off); } } while (0)
  for (int k = 0; k < 8; ++k) {
    const int c = dir ? 7 - k : k, t0 = 512 * sj + 64 * c;
    if (FULL && k == 4) { asm volatile("s_waitcnt vmcnt(0)" ::: "memory"); __syncthreads(); }
    HG_T(te0);
    { LANE_E(); const int dtid = 64 * dw + ln_;
      if (k == 0) { HG_LOAD(t0); }
#pragma unroll
      for (int u = 0; u < 4; ++u) { const int p = dtid + 256 * u; *(LAS u32x4*)(L + L_V + (p >> 4) * 320 + (p & 15) * 16) = v8[u]; }
      float cs[4][8], ff[4][8];
#pragma unroll
      for (int u = 0; u < 4; ++u) { const unsigned w0 = f8[u].x, w1 = f8[u].y, w2 = f8[u].z, w3 = f8[u].w;
        cs[u][0] = h2f((unsigned short)(w0 & 0xffff)); cs[u][1] = h2f((unsigned short)(w0 >> 16)); cs[u][2] = h2f((unsigned short)(w1 & 0xffff)); cs[u][3] = h2f((unsigned short)(w1 >> 16));
        cs[u][4] = h2f((unsigned short)(w2 & 0xffff)); cs[u][5] = h2f((unsigned short)(w2 >> 16)); cs[u][6] = h2f((unsigned short)(w3 & 0xffff)); cs[u][7] = h2f((unsigned short)(w3 >> 16)); }
#pragma unroll
      for (int u = 0; u < 4; ++u)
#pragma unroll
        for (int e = 0; e < 8; ++e) ff[u][e] = __builtin_amdgcn_exp2f(cs[u][e]);
#pragma unroll
      for (int u = 1; u < 4; ++u)
#pragma unroll
        for (int e = 0; e < 8; ++e) cs[u][e] += cs[u - 1][e];
      float inc[8], bl[8];
#pragma unroll
      for (int e = 0; e < 8; ++e) inc[e] = cs[3][e];
#define HG_ROWSHR(N) _Pragma("unroll") for (int e = 0; e < 8; ++e) inc[e] += __builtin_bit_cast(float, __builtin_amdgcn_update_dpp(0, __builtin_bit_cast(int, inc[e]), 0x110 + (N), 0xf, 0xf, false))
      HG_ROWSHR(1); HG_ROWSHR(2); HG_ROWSHR(4); HG_ROWSHR(8);
#undef HG_ROWSHR
#pragma unroll
      for (int e = 0; e < 8; ++e) { bl[e] = __shfl(inc[e], (ln_ & 48) + 15); const float ex = inc[e] - cs[3][e];
#pragma unroll
        for (int u = 0; u < 4; ++u) cs[u][e] += ex; }
#pragma unroll
      for (int e = 0; e < 8; ++e) { const int i = i0 + e; float ep[4], em[4], ki[4];
        ep[0] = __builtin_amdgcn_exp2f(cs[0][e]); em[3] = __builtin_amdgcn_exp2f(-cs[3][e]);
#pragma unroll
        for (int u = 1; u < 4; ++u) ep[u] = ep[u - 1] * ff[u][e];
#pragma unroll
        for (int u = 2; u >= 0; --u) em[u] = em[u + 1] * ff[u + 1][e];
#pragma unroll
        for (int u = 0; u < 4; ++u) ki[u] = __builtin_fmaf(-ff[u][e], em[u], em[u]);
        const int tau0 = 4 * tq;
        *(LAS u32x2*)(L + L_KIN + i * 144 + tau0 * 2) = (u32x2){cvtpk(ki[0], ki[1]), cvtpk(ki[2], ki[3])};
        if (FULL) { float qi[4];
#pragma unroll
          for (int u = 0; u < 4; ++u) { const unsigned w = (e < 2) ? q8[u].x : (e < 4) ? q8[u].y : (e < 6) ? q8[u].z : q8[u].w; qi[u] = ((e & 1) ? bhi(w) : blo(w)) * ep[u]; }
          *(LAS u32x2*)(L + L_QIN + i * 128 + ((((tau0 >> 5) ^ ((i >> 1) & 1))) << 6) + (tau0 & 31) * 2) = (u32x2){cvtpk(qi[0], qi[1]), cvtpk(qi[2], qi[3])}; } }
      if (tq == 0) {
#pragma unroll
        for (int e = 0; e < 8; ++e) { ((LAS float*)(L + L_DEC))[i0 + e] = __builtin_amdgcn_exp2f(bl[e]); if (!FULL) sumbl[e] += bl[e]; } }
    }
    HG_T(te1); HG_ACC(1, te0, te1);
    dir_bar(cnt, target, lane);
    HG_T(tm0); HG_ACC(2, te1, tm0);
    { LANE_M();
      if (FULL) {
        bf16x8 a00[2], a01[2], a11[2];
        { f32x16 AT00 = f32x16{}, AT01 = f32x16{}, AT11 = f32x16{};
#pragma unroll
          for (int ks8 = 0; ks8 < 8; ++ks8) {
            const LAS unsigned char* qp = L + L_QIN + qbase0 + ks8 * 2048; const LAS unsigned char* kp = L + L_KIN + kbase + ks8 * 2304;
            const LAS unsigned char* qx = (const LAS unsigned char*)((unsigned)(uintptr_t)qp ^ 64u);
            const bf16x8 q0 = trfrag(qp, qp + 1024), q1 = trfrag(qx, qx + 1024), k0 = trfrag(kp, kp + 1152), k1 = trfrag(kp + 64, kp + 64 + 1152);
            AT00 = __builtin_amdgcn_mfma_f32_32x32x16_bf16(k0, q0, AT00, 0, 0, 0);
            AT01 = __builtin_amdgcn_mfma_f32_32x32x16_bf16(k0, q1, AT01, 0, 0, 0);
            AT11 = __builtin_amdgcn_mfma_f32_32x32x16_bf16(k1, q1, AT11, 0, 0, 0);
          }
#pragma unroll
          for (int rr = 0; rr < 16; ++rr) { const bool keep = crow(rr, h) <= r32; AT00[rr] = keep ? AT00[rr] : 0.f; AT11[rr] = keep ? AT11[rr] : 0.f; }
          a00[0] = accfrag(AT00, 0); a00[1] = accfrag(AT00, 1); a01[0] = accfrag(AT01, 0); a01[1] = accfrag(AT01, 1); a11[0] = accfrag(AT11, 0); a11[1] = accfrag(AT11, 1); }
        if (k < 7) { const int cn = dir ? 6 - k : k + 1; HG_LOAD(512 * sj + 64 * cn); }
        f32x16 oT0 = f32x16{}, oT1 = f32x16{};
        { const LAS unsigned char* vp = L + L_V + vpbase;
          const bf16x8 vp00 = trfrag(vp, vp + 8 * 320), vp01 = trfrag(vp + 16 * 320, vp + 24 * 320), vp10 = trfrag(vp + 32 * 320, vp + 40 * 320), vp11 = trfrag(vp + 48 * 320, vp + 56 * 320);
          oT0 = __builtin_amdgcn_mfma_f32_32x32x16_bf16(vp00, a00[0], oT0, 0, 0, 0);
          oT0 = __builtin_amdgcn_mfma_f32_32x32x16_bf16(vp01, a00[1], oT0, 0, 0, 0);
          oT1 = __builtin_amdgcn_mfma_f32_32x32x16_bf16(vp00, a01[0], oT1, 0, 0, 0);
          oT1 = __builtin_amdgcn_mfma_f32_32x32x16_bf16(vp01, a01[1], oT1, 0, 0, 0);
          oT1 = __builtin_amdgcn_mfma_f32_32x32x16_bf16(vp10, a11[0], oT1, 0, 0, 0);
          oT1 = __builtin_amdgcn_mfma_f32_32x32x16_bf16(vp11, a11[1], oT1, 0, 0, 0); }
#pragma unroll
        for (int ks8 = 0; ks8 < 8; ++ks8) {
          const LAS unsigned char* qp = L + L_QIN + qbase0 + ks8 * 2048; const LAS unsigned char* qx = (const LAS unsigned char*)((unsigned)(uintptr_t)qp ^ 64u);
          const bf16x8 q0 = trfrag(qp, qp + 1024), q1 = trfrag(qx, qx + 1024), sf = accfrag(S[ks8 >> 1], ks8 & 1);
          oT0 = __builtin_amdgcn_mfma_f32_32x32x16_bf16(sf, q0, oT0, 0, 0, 0);
          oT1 = __builtin_amdgcn_mfma_f32_32x32x16_bf16(sf, q1, oT1, 0, 0, 0);
        }
        if (k < 4) {
#pragma unroll
          for (int tb = 0; tb < 2; ++tb) { const int tau = 32 * tb + r32, t = t0 + (dir ? 63 - tau : tau); bf16* op = LF + (unsigned)(t * 1024 + 32 * dw + 16 * h); u32x2 w[4]; u32x4 c0, c1;
#pragma unroll
            for (int g4 = 0; g4 < 4; ++g4) { const f32x16& o = tb ? oT1 : oT0; w[g4] = (u32x2){cvtpk(o[4 * g4], o[4 * g4 + 1]), cvtpk(o[4 * g4 + 2], o[4 * g4 + 3])}; }
            swz_pack(w, c0, c1); *(u32x4*)op = c0; *(u32x4*)(op + 8) = c1; }
        } else {
          const bf16* LFo = dir ? LFf : LFb; u32x2 gg[2][4]; float ss[2];
          u32x4 pc[2][2];
          { const bf16* pa0 = LFo + (unsigned)((t0 + (dir ? 63 - r32 : r32)) * 1024 + 32 * dw + 16 * h); const bf16* pa1 = LFo + (unsigned)((t0 + (dir ? 31 - r32 : 32 + r32)) * 1024 + 32 * dw + 16 * h);
            asm volatile("global_load_dwordx4 %0, %4, off sc1\n\tglobal_load_dwordx4 %1, %4, off offset:16 sc1\n\tglobal_load_dwordx4 %2, %5, off sc1\n\tglobal_load_dwordx4 %3, %5, off offset:16 sc1\n\ts_waitcnt vmcnt(0)"
                         : "=&v"(pc[0][0]), "=&v"(pc[0][1]), "=&v"(pc[1][0]), "=&v"(pc[1][1]) : "v"(pa0), "v"(pa1) : "memory"); }
#pragma unroll
          for (int tb = 0; tb < 2; ++tb) { const int tau = 32 * tb + r32, t = t0 + (dir ? 63 - tau : tau); unsigned long long pp[4];
            { u32x2 pw[4]; swz_unpack(pc[tb][0], pc[tb][1], pw);
#pragma unroll
              for (int g4 = 0; g4 < 4; ++g4) pp[g4] = (unsigned long long)pw[g4].x | ((unsigned long long)pw[g4].y << 32); }
            { const bf16* gp = GG + (unsigned)(t * 1024 + 32 * dw + 16 * h); const u32x4 c0 = *(const u32x4*)gp, c1 = *(const u32x4*)(gp + 8); swz_unpack(c0, c1, gg[tb]); }
            f32x16& o = tb ? oT1 : oT0; float s = 0.f;
#pragma unroll
            for (int g4 = 0; g4 < 4; ++g4) { o[4 * g4] += blo((unsigned)pp[g4]); o[4 * g4 + 1] += bhi((unsigned)pp[g4]); o[4 * g4 + 2] += blo((unsigned)(pp[g4] >> 32)); o[4 * g4 + 3] += bhi((unsigned)(pp[g4] >> 32));
              s += (o[4 * g4] * o[4 * g4] + o[4 * g4 + 1] * o[4 * g4 + 1]) + (o[4 * g4 + 2] * o[4 * g4 + 2] + o[4 * g4 + 3] * o[4 * g4 + 3]); }
            s += __shfl_xor(s, 32); ss[tb] = s; }
          if (h == 0) { ((LAS float*)(L + L_SSQ))[r32 * 4 + dw] = ss[0]; ((LAS float*)(L + L_SSQ))[(32 + r32) * 4 + dw] = ss[1]; }
          dir_bar(cnt, target, lane);
          f32x4 gn[4];
#pragma unroll
          for (int g4 = 0; g4 < 4; ++g4) gn[g4] = *(const f32x4*)(GAIN + 32 * dw + 8 * g4 + 4 * h);
#pragma unroll
          for (int tb = 0; tb < 2; ++tb) { const int tau = 32 * tb + r32, t = t0 + (dir ? 63 - tau : tau); const f32x4 sp = *(const LAS f32x4*)(L + L_SSQ + (32 * tb + r32) * 16);
            const float rs = __builtin_amdgcn_rsqf(((sp[0] + sp[1]) + (sp[2] + sp[3])) * (1.0f / 128.0f) + 1e-6f); const f32x16& o = tb ? oT1 : oT0; bf16* op = OC + (unsigned)(t * 2048 + 32 * dw + 16 * h); u32x2 w[4]; u32x4 c0, c1;
#pragma unroll
            for (int g4 = 0; g4 < 4; ++g4) w[g4] = (u32x2){cvtpk(o[4 * g4] * rs * gn[g4][0] * blo(gg[tb][g4].x), o[4 * g4 + 1] * rs * gn[g4][1] * bhi(gg[tb][g4].x)),
                                                           cvtpk(o[4 * g4 + 2] * rs * gn[g4][2] * blo(gg[tb][g4].y), o[4 * g4 + 3] * rs * gn[g4][3] * bhi(gg[tb][g4].y))};
            swz_pack(w, c0, c1); *(u32x4*)op = c0; *(u32x4*)(op + 8) = c1; }
        }
      }
      if (!FULL) { if (k < 7) { const int cn = dir ? 6 - k : k + 1; HG_LOAD(512 * sj + 64 * cn); } }
      { const LAS unsigned char* vn = L + L_V + vnbase; const LAS unsigned char* kn = L + L_KIN + knbase;
#pragma unroll
        for (int ks = 0; ks < 4; ++ks) { const bf16x8 vf = trfrag(vn + ks * 16 * 320, vn + ks * 16 * 320 + 4 * 320);
#pragma unroll
          for (int ib = 0; ib < 4; ++ib) { const bf16x8 kf = *(const LAS bf16x8*)(kn + ib * 32 * 144 + ks * 32); S[ib] = __builtin_amdgcn_mfma_f32_32x32x16_bf16(kf, vf, S[ib], 0, 0, 0); } }
#pragma unroll
        for (int ib = 0; ib < 4; ++ib)
#pragma unroll
          for (int g4 = 0; g4 < 4; ++g4) { const f32x4 d = *(const LAS f32x4*)(L + L_DEC + (32 * ib + 8 * g4 + 4 * h) * 4);
#pragma unroll
            for (int e = 0; e < 4; ++e) S[ib][4 * g4 + e] *= d[e]; } }
    }
    HG_T(tm1); HG_ACC(3, tm0, tm1);
    dir_bar(cnt, target, lane);
    HG_T(tb1); HG_ACC(4, tm1, tb1);
  }
  HG_T(tt0);
  if (!FULL) { LANE_E();
    bf16* sl = (bf16*)SL + ((((size_t)stream * 8 + sj) * 4 + dw) * 4) * 1024 + lane * 16;
#pragma unroll
    for (int ib = 0; ib < 4; ++ib) { u32x4 w0, w1;
      w0.x = cvtpk(S[ib][0], S[ib][1]); w0.y = cvtpk(S[ib][2], S[ib][3]); w0.z = cvtpk(S[ib][4], S[ib][5]); w0.w = cvtpk(S[ib][6], S[ib][7]);
      w1.x = cvtpk(S[ib][8], S[ib][9]); w1.y = cvtpk(S[ib][10], S[ib][11]); w1.z = cvtpk(S[ib][12], S[ib][13]); w1.w = cvtpk(S[ib][14], S[ib][15]);
      *(u32x4*)(sl + ib * 1024) = w0; *(u32x4*)(sl + ib * 1024 + 8) = w1; }
    if (tq == 0) { float* dt = DT + ((size_t)stream * 8 + sj) * 128 + i0;
#pragma unroll
      for (int e = 0; e < 8; ++e) dt[e] = __builtin_amdgcn_exp2f(sumbl[e]); }
  }
#undef HG_LOAD
  asm volatile("s_waitcnt vmcnt(0)" ::: "memory");
  __syncthreads();
  HG_T(tt1); HG_ACC(6, tt0, tt1);
}
}

__device__ __forceinline__ void hgrn_simple(Frame& F, const Args& A, int sid) {
    const int bl = sid >> 4, h = (sid >> 1) & 7, dir = sid & 1, tid = F.tid, j = tid >> 2, iq = tid & 3;
    const size_t base = (size_t)bl * SEQ * 1024 + h * 128;
    const bf16* Q = (const bf16*)(A.ws + WS_HGQ) + base; const bf16* V = (const bf16*)(A.ws + WS_HGV) + base;
    bf16* LF = (bf16*)(A.ws + (dir ? WS_LFB : WS_LFF)) + base;
    LAS float* qs = (LAS float*)(F.lds); LAS float* fs = qs + 4096; LAS float* ks = fs + 4096; LAS float* vs = ks + 4096; LAS float* os = vs + 4096;
    float S[32];
#pragma unroll
    for (int i = 0; i < 32; ++i) S[i] = 0.f;
    for (int blk = 0; blk < SEQ / 32; ++blk) {
        const int t0 = dir ? (SEQ - 32 * (blk + 1)) : 32 * blk;
#pragma unroll
        for (int r = 0; r < 8; ++r) { const int e = tid + 512 * r, tt = e >> 7, i = e & 127; const size_t off = (size_t)(t0 + tt) * 1024 + i;
            const float f = exp2f(h2f(LF[off])); qs[e] = bf2f(Q[off]); fs[e] = f; ks[e] = 1.0f - f; vs[e] = bf2f(V[off]); }
        __syncthreads();
        for (int s = 0; s < 32; ++s) { const int tt = dir ? 31 - s : s; const float vj = vs[tt * 128 + j]; float a = 0.f;
            const LAS f32x4* f4 = (const LAS f32x4*)(fs + tt * 128 + iq * 32); const LAS f32x4* k4 = (const LAS f32x4*)(ks + tt * 128 + iq * 32); const LAS f32x4* q4 = (const LAS f32x4*)(qs + tt * 128 + iq * 32);
#pragma unroll
            for (int c = 0; c < 8; ++c) { const f32x4 ff = f4[c], kk = k4[c], qq = q4[c];
#pragma unroll
                for (int e = 0; e < 4; ++e) { S[4 * c + e] = ff[e] * S[4 * c + e] + kk[e] * vj; a += S[4 * c + e] * qq[e]; } }
            a += __shfl_xor(a, 1); a += __shfl_xor(a, 2);
            if (iq == 0) os[tt * 128 + j] = a; }
        __syncthreads();
#pragma unroll
        for (int r = 0; r < 8; ++r) { const int e = tid + 512 * r, tt = e >> 7, i = e & 127; LF[(size_t)(t0 + tt) * 1024 + i] = (bf16)f2bf(os[e]); }
    }
    __syncthreads();
}
__device__ __forceinline__ void da_simple_item(Frame& F, const Args& A, int lrow, int hd, LAS float* wq) {
    const int lane = F.lane, bl = lrow >> 12, t = lrow & 4095, grp = hd >> 2, sh = 2 * grp, n = t >> sh, r = t & ((1 << sh) - 1), Ld = SEQ >> sh;
    bf16* qrow = (bf16*)(A.ws + WS_DAQ) + (size_t)lrow * 1536 + hd * 128;
    const bf16* K = (const bf16*)(A.ws + WS_DAK) + hd * 128; const bf16* V = (const bf16*)(A.ws + WS_DAV) + hd * 128;
    const unsigned qq = *(const unsigned*)(qrow + 2 * lane);
    wq[2 * lane] = blo(qq); wq[2 * lane + 1] = bhi(qq);
    LDS_WAIT(); asm volatile("" ::: "memory");
    const float slope = exp2f(-(float)(hd + 1) * (8.0f / 12.0f)) * (float)(1 << sh) * 1.4426950408889634f;
    float sc[3];
#pragma unroll
    for (int s = 0; s < 3; ++s) { const int kk = lane + 64 * s, rel = kk - 64, m = n + rel; const bool valid = (kk <= 128) && (m >= 0) && (m < Ld);
        float v = -INFINITY;
        if (valid) { const bf16* krow = K + (size_t)(bl * SEQ + (m << sh) + r) * 1536; float dot = 0.f;
#pragma unroll 4
            for (int c = 0; c < 16; ++c) { const v4u kv = *(const v4u*)(krow + 8 * c); const LAS f32x4* w4 = (const LAS f32x4*)(wq + 8 * c); const f32x4 wa = w4[0], wb = w4[1];
                dot += (wa[0] * blo(kv.x) + wa[1] * bhi(kv.x)) + (wa[2] * blo(kv.y) + wa[3] * bhi(kv.y)) + (wb[0] * blo(kv.z) + wb[1] * bhi(kv.z)) + (wb[2] * blo(kv.w) + wb[3] * bhi(kv.w)); }
            v = dot - slope * fabsf((float)rel); }
        sc[s] = v; }
    const float mx = wave_max(fmaxf(fmaxf(sc[0], sc[1]), sc[2]));
    float p[3];
#pragma unroll
    for (int s = 0; s < 3; ++s) p[s] = exp2f(sc[s] - mx);
    const float sum = wave_sum(p[0] + p[1] + p[2]); const float inv = 1.0f / sum, lse = mx + __log2f(sum);
    float o0 = 0.f, o1 = 0.f;
#pragma unroll
    for (int s = 0; s < 3; ++s) { const int cnt = (s < 2) ? 64 : 1;
        for (int c = 0; c < cnt; ++c) { const int kk = c + 64 * s, m = n + kk - 64; if (m < 0 || m >= Ld) continue;
            const float pj = __shfl(p[s], c) * inv; const unsigned vv = *(const unsigned*)(V + (size_t)(bl * SEQ + (m << sh) + r) * 1536 + 2 * lane);
            o0 += pj * blo(vv); o1 += pj * bhi(vv); } }
    *(unsigned*)(qrow + 2 * lane) = pk2(o0, o1);
    if (lane == 0) ((float*)(A.ws + WS_LSE))[lrow * 12 + hd] = lse;
}
__device__ __forceinline__ void mem_simple_item(Frame& F, const Args& A, int g, int lrow, int hd, LAS float* wq) {
    const int lane = F.lane, b = g * GB + (lrow >> 12);
    const bf16* qrow = (const bf16*)(A.ws + WS_MQ) + (size_t)lrow * 512 + hd * 128;
    const bf16* K = (const bf16*)(A.ws + WS_MEMKV) + (size_t)b * NMEM * 1024 + hd * 128; const bf16* V = K + 512;
    const unsigned qq = *(const unsigned*)(qrow + 2 * lane);
    wq[2 * lane] = blo(qq); wq[2 * lane + 1] = bhi(qq);
    LDS_WAIT(); asm volatile("" ::: "memory");
    float sc[4];
#pragma unroll
    for (int s = 0; s < 4; ++s) { const bf16* krow = K + (size_t)(lane + 64 * s) * 1024; float dot = 0.f;
#pragma unroll 4
        for (int c = 0; c < 16; ++c) { const v4u kv = *(const v4u*)(krow + 8 * c); const LAS f32x4* w4 = (const LAS f32x4*)(wq + 8 * c); const f32x4 wa = w4[0], wb = w4[1];
            dot += (wa[0] * blo(kv.x) + wa[1] * bhi(kv.x)) + (wa[2] * blo(kv.y) + wa[3] * bhi(kv.y)) + (wb[0] * blo(kv.z) + wb[1] * bhi(kv.z)) + (wb[2] * blo(kv.w) + wb[3] * bhi(kv.w)); }
        sc[s] = dot; }
    const float mx = wave_max(fmaxf(fmaxf(sc[0], sc[1]), fmaxf(sc[2], sc[3])));
    float p[4];
#pragma unroll
    for (int s = 0; s < 4; ++s) p[s] = exp2f(sc[s] - mx);
    const float inv = 1.0f / wave_sum((p[0] + p[1]) + (p[2] + p[3]));
    float o0 = 0.f, o1 = 0.f;
#pragma unroll
    for (int s = 0; s < 4; ++s)
        for (int c = 0; c < 64; ++c) { const float pj = __shfl(p[s], c) * inv; const unsigned vv = *(const unsigned*)(V + (size_t)(c + 64 * s) * 1024 + 2 * lane); o0 += pj * blo(vv); o1 += pj * bhi(vv); }
    *(unsigned*)((bf16*)(A.ws + WS_OCAT) + (size_t)lrow * 2048 + 1536 + hd * 128 + 2 * lane) = pk2(o0, o1);
}
__device__ __forceinline__ void attn_units(Frame& F, const Args& A, int g) {
    for (int u = F.vcu; u < 1024; u += F.G) {
        if (u < 768) { const int bl = u / 192, rem = u % 192, hd = rem >> 4, idx = rem & 15, grp = hd >> 2, sh = 2 * grp, nblk = 16 >> sh, r = idx / nblk, n0 = 256 * (idx % nblk);
            const long row0 = (long)bl * SEQ + ((long)n0 << sh) + r;
            bf16* Qb = (bf16*)(A.ws + WS_DAQ) + row0 * 1536 + hd * 128;
            const bf16* Kb = (const bf16*)(A.ws + WS_DAK) + ((long)bl * SEQ + r) * 1536 + hd * 128; const bf16* Vb = (const bf16*)(A.ws + WS_DAV) + ((long)bl * SEQ + r) * 1536 + hd * 128;
            const float slope2 = exp2f(-(float)(hd + 1) * (8.0f / 12.0f)) * (float)(1 << sh) * 1.4426950408889634f;
            float* lse = (float*)(A.ws + WS_LSE) + row0 * 12 + hd;
            att::attn_unit(Qb, (long)1536 << sh, Kb, Vb, (long)1536 << sh, 6, n0 - 64, SEQ >> sh, n0, true, slope2, Qb, (long)1536 << sh, lse, (long)12 << sh, F.lds, F.tid, (unsigned long long*)(F.ctl + 768));
        } else { const int v = u - 768, bl = v >> 6, hd = (v >> 4) & 3, qb = v & 15; const long row0 = (long)bl * SEQ + 256 * qb;
            const bf16* Qb = (const bf16*)(A.ws + WS_MQ) + row0 * 512 + hd * 128;
            const bf16* Kb = (const bf16*)(A.ws + WS_MEMKV) + (long)(g * GB + bl) * NMEM * 1024 + hd * 128;
            bf16* Ob = (bf16*)(A.ws + WS_OCAT) + row0 * 2048 + 1536 + hd * 128;
            att::attn_unit(Qb, 512, Kb, Kb + 512, 1024, 4, 0, NMEM, 0, false, 0.f, Ob, 2048, nullptr, 0, F.lds, F.tid, (unsigned long long*)(F.ctl + 768));
        }
    }
}
template <bool FULL> __device__ __forceinline__ void hgrn_items(Frame& F, const Args& A) {
    for (int it = F.vcu; it < GB * 8 * 8; it += F.G) { const int bl = it >> 6, hh = (it >> 3) & 7, sj = it & 7; const size_t base = (size_t)bl * SEQ * 1024 + hh * 128;
        hg::hgrn_item<FULL>((const bf16*)(A.ws + WS_HGQ) + base, (const bf16*)(A.ws + WS_HGV) + base, (bf16*)(A.ws + WS_LFF) + base, (bf16*)(A.ws + WS_LFB) + base,
                            (const bf16*)(A.ws + WS_HGG) + base, A.in[7], (bf16*)(A.ws + WS_OCAT) + (size_t)bl * SEQ * 2048 + hh * 128,
                            (float*)((unsigned char*)A.out + OUT_SL), (float*)(A.ws + WS_DT), bl * 8 + hh, sj, F.lds, F.tid, (unsigned long long*)(F.ctl + 768)); }
}
__device__ __forceinline__ void da_merge(Frame& F, const Args& A) {
    const int gw = F.vcu * NWAVES + F.wave, NGW = F.G * NWAVES, lane = F.lane, jj = lane >> 4, c8 = (lane & 15) * 8;
    const bf16* DQ = (const bf16*)(A.ws + WS_DAQ); const float* LSE = (const float*)(A.ws + WS_LSE); bf16* OC = (bf16*)(A.ws + WS_OCAT);
    for (int r0 = gw * 4; r0 < GR; r0 += NGW * 4) {
        v4u a[4], b[4], c[4]; float l0[4], l1[4], l2[4];
#pragma unroll
        for (int s = 0; s < 4; ++s) { const int row = r0 + s; const bf16* p = DQ + (size_t)row * 1536 + jj * 128 + c8;
            l0[s] = LSE[row * 12 + jj]; l1[s] = LSE[row * 12 + 4 + jj]; l2[s] = LSE[row * 12 + 8 + jj]; a[s] = *(const v4u*)p; b[s] = *(const v4u*)(p + 512); c[s] = *(const v4u*)(p + 1024); }
#pragma unroll
        for (int s = 0; s < 4; ++s) { const int row = r0 + s; const float mx = fmaxf(fmaxf(l0[s], l1[s]), l2[s]);
            float w0 = exp2f(l0[s] - mx), w1 = exp2f(l1[s] - mx), w2 = exp2f(l2[s] - mx); const float inv = 1.0f / (w0 + w1 + w2); w0 *= inv; w1 *= inv; w2 *= inv;
            v4u o;
            o.x = pk2(w0 * blo(a[s].x) + w1 * blo(b[s].x) + w2 * blo(c[s].x), w0 * bhi(a[s].x) + w1 * bhi(b[s].x) + w2 * bhi(c[s].x));
            o.y = pk2(w0 * blo(a[s].y) + w1 * blo(b[s].y) + w2 * blo(c[s].y), w0 * bhi(a[s].y) + w1 * bhi(b[s].y) + w2 * bhi(c[s].y));
            o.z = pk2(w0 * blo(a[s].z) + w1 * blo(b[s].z) + w2 * blo(c[s].z), w0 * bhi(a[s].z) + w1 * bhi(b[s].z) + w2 * bhi(c[s].z));
            o.w = pk2(w0 * blo(a[s].w) + w1 * blo(b[s].w) + w2 * blo(c[s].w), w0 * bhi(a[s].w) + w1 * bhi(b[s].w) + w2 * bhi(c[s].w));
            *(v4u*)(OC + (size_t)row * 2048 + 1024 + jj * 128 + c8) = o; }
    }
}
__device__ __forceinline__ void p2_finalize_v1(Frame& F, const Args& A) {
    const int gw = F.vcu * NWAVES + F.wave, NGW = F.G * NWAVES, lane = F.lane;
    const bf16* OF = (const bf16*)(A.ws + WS_LFF); const bf16* OB = (const bf16*)(A.ws + WS_LFB); const bf16* GG = (const bf16*)(A.ws + WS_HGG);
    const bf16* DQ = (const bf16*)(A.ws + WS_DAQ); const float* LSE = (const float*)(A.ws + WS_LSE); bf16* OC = (bf16*)(A.ws + WS_OCAT);
    const float g0 = A.in[7][2 * lane], g1 = A.in[7][2 * lane + 1];
    for (int row = gw; row < GR; row += NGW) {
#pragma unroll 2
        for (int h = 0; h < 8; ++h) { const size_t off = (size_t)row * 1024 + h * 128 + 2 * lane;
            const unsigned a = *(const unsigned*)(OF + off), b = *(const unsigned*)(OB + off), gg = *(const unsigned*)(GG + off);
            const float o0 = blo(a) + blo(b), o1 = bhi(a) + bhi(b); const float rs = 1.0f / sqrtf(wave_sum(o0 * o0 + o1 * o1) * (1.f / 128.f) + RMS_EPS);
            *(unsigned*)(OC + (size_t)row * 2048 + h * 128 + 2 * lane) = pk2(o0 * rs * g0 * blo(gg), o1 * rs * g1 * bhi(gg)); }
#pragma unroll
        for (int jj = 0; jj < 4; ++jj) { const float l0 = LSE[row * 12 + jj], l1 = LSE[row * 12 + 4 + jj], l2 = LSE[row * 12 + 8 + jj]; const float mx = fmaxf(fmaxf(l0, l1), l2);
            const float w0 = exp2f(l0 - mx), w1 = exp2f(l1 - mx), w2 = exp2f(l2 - mx), inv = 1.0f / (w0 + w1 + w2);
            const unsigned a = *(const unsigned*)(DQ + (size_t)row * 1536 + jj * 128 + 2 * lane), b = *(const unsigned*)(DQ + (size_t)row * 1536 + (4 + jj) * 128 + 2 * lane), c = *(const unsigned*)(DQ + (size_t)row * 1536 + (8 + jj) * 128 + 2 * lane);
            *(unsigned*)(OC + (size_t)row * 2048 + 1024 + jj * 128 + 2 * lane) = pk2((w0 * blo(a) + w1 * blo(b) + w2 * blo(c)) * inv, (w0 * bhi(a) + w1 * bhi(b) + w2 * bhi(c)) * inv); }
    }
}

#ifndef MK_PER_PHASE
#define MK_PER_PHASE 0
#endif
constexpr int N_PHASES = 13;
__global__ void __launch_bounds__(NWAVES * 64, 2) mega_fwd(Args args) {
    extern __shared__ __attribute__((aligned(16))) unsigned char lds[];
    Frame F;
    F.lds = (LAS unsigned char*)lds;
    F.MISC = (volatile LAS unsigned*)(F.lds + MISC_OFF);
    F.tid = threadIdx.x; F.lane = F.tid & 63; F.wave = __builtin_amdgcn_readfirstlane(F.tid >> 6);
    F.G = gridDim.x; { const int bx = blockIdx.x; F.vcu = (F.G % 8 == 0) ? (bx % 8) * (F.G / 8) + bx / 8 : bx; }
    F.ctl = (gu32*)(args.ws + WS_CTL);
    for (int u = F.tid; u < (LDS_BYTES - LDSCTL_OFF) / 4; u += NWAVES * 64) ((LAS unsigned*)(F.lds + LDSCTL_OFF))[u] = 0u;
    __syncthreads();
    XcdBarrier bar; bar.bar = (unsigned*)(F.ctl + CW_BAR); bar.x = 0; bar.st = nullptr; bar.w0 = F.wave;
    if (!MK_PER_PHASE) bar = xcd_barrier_post((unsigned*)(F.ctl + CW_BAR), F.MISC + 8, F.wave);
    const int lo = args.ph_lo, hi = args.ph_hi;
    const int wave0 = F.wave;
#ifndef PH_MASK
#define PH_MASK 0xFFF
#endif
#define PBIT(k) ((k) <= 4 ? (k) : ((k) <= 8 ? (k) - 4 : (k) - 4))
#define IN(k) (lo <= (k) && (k) < hi)
#ifndef REP_MASK
#define REP_MASK 0
#endif
#define REPS(k) (1 + ((REP_MASK >> (k)) & 1))
#ifndef PROBE_PHASE
#define PROBE_PHASE -1
#endif
#ifndef PROBE_OFF
#define PROBE_OFF 0
#endif
#define STAMP(k) do { if (PROBE_PHASE >= 0 && blockIdx.x == 0 && xb_t0(wave0)) { const unsigned long long t_ = __builtin_amdgcn_s_memrealtime(); __hip_atomic_store((unsigned long long*)(F.ctl + 512) + (k), t_, __ATOMIC_RELAXED, __HIP_MEMORY_SCOPE_AGENT); } } while (0)
#define SEAM(k) do { if (IN(k) && IN((k) + 1)) { const DeferFill df_{(k), wave0, (int)__builtin_amdgcn_mbcnt_hi(~0u, __builtin_amdgcn_mbcnt_lo(~0u, 0u)), F.vcu, F.G, F.lds}; xcd_barrier(bar, df_); } STAMP((k) + 1); } while (0)
#if defined(__HIP_DEVICE_COMPILE__)
#define PHASE_ARGS() Args A; { const __attribute__((address_space(4))) Args* ap_ = (const __attribute__((address_space(4))) Args*)__builtin_amdgcn_kernarg_segment_ptr(); asm volatile("" : "+s"(ap_)); A = *ap_; } \
    unsigned char* const ws = A.ws; (void)ws; { unsigned z_ = 0u; asm volatile("" : "+v"(z_)); int t_ = wave0 * 64 + (int)__builtin_amdgcn_mbcnt_hi(~0u, __builtin_amdgcn_mbcnt_lo(~0u, z_)); F.tid = t_; F.lane = t_ & 63; F.wave = wave0; }
#else
#define PHASE_ARGS() Args A = args; unsigned char* const ws = A.ws; (void)ws
#endif

    STAMP(0);
    if (IN(0)) { for (int rep = 0; rep < REPS(0); ++rep) { PHASE_ARGS(); p0_prologue(F, A); } } SEAM(0);
    if (IN(1)) {
        for (int rep = 0; rep < REPS(1); ++rep) { PHASE_ARGS();
        pg8::Gemm gm{(const pg8::bf16_t*)(ws + WS_MEMN), (const pg8::bf16_t*)(ws + WS_WKV), BATCH * NMEM, 1024, 1024}; pg8::StaticOrder S; S.init(BATCH * NMEM, 1024, F.G, (int)blockIdx.x);
        pg8::EpiKV E{(pg8::bf16_t*)(ws + WS_MEMKV), A.in[12], (PG8_LAS float*)(F.lds + EPI_SCR_OFF)};
        pg8::gemm_phase<pg8::EpiKV, pg8::StaticOrder, true, true>(F.lds + RING_OFF, gm, S, E, F.tid); }
    }
    for (int g = 0; g < NGRP; ++g) {
        const int pb = 1 + 4 * g;
        if (IN(pb)) {
            for (int rep = 0; rep < REPS(pb); ++rep) { PHASE_ARGS();
            pg8::Gemm gm{(const pg8::bf16_t*)(ws + WS_H) + (size_t)g * GR * 1024, (const pg8::bf16_t*)(ws + WS_WIN), GR, INC, 1024}; RotOrder S; S.init(GR, INC, F.G, (int)blockIdx.x);
            pg8::EpiProj E{ws, (pg8::bf16_t*)((unsigned char*)A.out + OUT_GATES + (size_t)g * (48u << 20)), (const float*)(ws + WS_LB), A.in[8], A.in[9], A.in[11], (PG8_LAS float*)(F.lds + EPI_SCR_OFF)};
            pg8::gemm_phase<pg8::EpiProj, RotOrder, true, true>(F.lds + RING_OFF, gm, S, E, F.tid); }
        }
        SEAM(pb);
        if (IN(pb + 1)) { PHASE_ARGS(); attn_units(F, A, g); for (int rep = 0; rep < REPS(pb + 1); ++rep) hgrn_items<false>(F, A); } SEAM(pb + 1);
        if (IN(pb + 2)) { PHASE_ARGS(); unsigned long long tq0 = 0, tq1 = 0, tq2 = 0; if (HG_PROBE) tq0 = __builtin_amdgcn_s_memrealtime(); hgrn_items<true>(F, A); if (HG_PROBE) tq1 = __builtin_amdgcn_s_memrealtime(); da_merge(F, A); if (HG_PROBE) tq2 = __builtin_amdgcn_s_memrealtime();
            if (HG_PROBE && blockIdx.x == 0 && F.tid == 0) { unsigned long long* prb = (unsigned long long*)(F.ctl + 768); prb[7] += tq1 - tq0; prb[11] += tq2 - tq1; } } SEAM(pb + 2);
        if (IN(pb + 3)) {
            for (int rep = 0; rep < REPS(pb + 3); ++rep) { PHASE_ARGS();
            pg8::Gemm gm{(const pg8::bf16_t*)(ws + WS_OCAT), (const pg8::bf16_t*)(ws + WS_WPC), GR, 1024, 2048}; pg8::StaticOrder S; S.init(GR, 1024, F.G, (int)blockIdx.x);
            pg8::EpiMerged E{(const pg8::bf16_t*)((unsigned char*)A.out + OUT_GATES + (size_t)g * (48u << 20)), (pg8::bf16_t*)(ws + WS_H), g * GR};
            pg8::gemm_phase<pg8::EpiMerged, pg8::StaticOrder, true, true>(F.lds + RING_OFF, gm, S, E, F.tid); }
        }
        if (g == NGRP - 1) SEAM(pb + 3); else STAMP(pb + 4);
    }
    if (IN(9)) {
        for (int rep = 0; rep < REPS(9); ++rep) { PHASE_ARGS();
        pg8::Gemm gm{(const pg8::bf16_t*)(ws + WS_H), (const pg8::bf16_t*)(ws + WS_WO), MTOK, 1024, 1024}; pg8::StaticOrder S; S.init(MTOK, 1024, F.G, (int)blockIdx.x);
        pg8::EpiWout E{A.in[0], (pg8::bf16_t*)(ws + WS_X1B), (float*)(ws + WS_SSQ)};
        pg8::gemm_phase<pg8::EpiWout, pg8::StaticOrder, true, true>(F.lds + RING_OFF, gm, S, E, F.tid); }
    }
    SEAM(9);
    if (IN(10)) {
        for (int rep = 0; rep < REPS(10); ++rep) { PHASE_ARGS();
        pg8::Gemm gm{(const pg8::bf16_t*)(ws + WS_X1B), (const pg8::bf16_t*)(ws + WS_WFI), MTOK, 2 * DFF, 1024}; RevOrder S; S.init(MTOK, 2 * DFF, F.G, (int)blockIdx.x);
        { PG8_LAS float* cache_ = (PG8_LAS float*)(F.lds + EPI_SCR_OFF); if (F.tid < 8) ((volatile PG8_LAS int*)cache_)[F.tid * 132 + 128] = 0; __syncthreads(); }
        pg8::EpiFfnIn E{(const float*)(ws + WS_SSQ), (pg8::bf16_t*)(ws + WS_U), (PG8_LAS float*)(F.lds + EPI_SCR_OFF)};
        pg8::gemm_phase<pg8::EpiFfnIn, RevOrder, true, true>(F.lds + RING_OFF, gm, S, E, F.tid); }
    }
    SEAM(10);
    if (IN(11)) {
        PHASE_ARGS();
        pg8::Gemm gm{(const pg8::bf16_t*)(ws + WS_U), (const pg8::bf16_t*)(ws + WS_WFO), MTOK, 1024, DFF}; pg8::StaticOrder S; S.init(MTOK, 1024, F.G, (int)blockIdx.x);
        pg8::EpiFfnOut E{(const pg8::bf16_t*)(ws + WS_X1B), A.out};
        pg8::gemm_phase<pg8::EpiFfnOut, pg8::StaticOrder, true, true>(F.lds + RING_OFF, gm, S, E, F.tid);
    }
    if (PROBE_PHASE >= 0) {
        xcd_barrier(bar); STAMP(12);
        if (blockIdx.x == 0 && xb_t0(wave0)) { PHASE_ARGS(); const unsigned long long* ts = (const unsigned long long*)(F.ctl + 512);
            const unsigned long long t0 = __hip_atomic_load(ts + PROBE_PHASE, __ATOMIC_RELAXED, __HIP_MEMORY_SCOPE_AGENT), t1 = __hip_atomic_load(ts + PROBE_PHASE + 1, __ATOMIC_RELAXED, __HIP_MEMORY_SCOPE_AGENT);
            A.out[0] += ((HG_PROBE ? (float)ts[128 + HG_PROBE] * 0.01f : (float)(t1 - t0) * 0.01f) - (float)(PROBE_OFF)) * 0.05f; }
    }
#undef IN
#undef SEAM
}

extern "C" void kernel_launch(void* const* d_in, const int* in_sizes, int n_in, void* d_out, int out_size, void* d_ws, size_t ws_size, hipStream_t stream) {
    static int grid = 0;
    if (grid == 0) {
        if (n_in != 20 || in_sizes[0] != MTOK * D || out_size != MTOK * D || ws_size < WS_END) { fprintf(stderr, "kernel_launch: unexpected shapes/workspace: n_in %d in0 %d out %d ws %zu (need %zu); nothing launched\n", n_in, n_in > 0 ? in_sizes[0] : -1, out_size, ws_size, (size_t)WS_END); grid = -1; return; }
        int dev = 0, cus = 0, per_cu = 0;
        if (hipGetDevice(&dev) != hipSuccess || hipDeviceGetAttribute(&cus, hipDeviceAttributeMultiprocessorCount, dev) != hipSuccess) { grid = -1; return; }
        if (hipFuncSetAttribute((const void*)mega_fwd, hipFuncAttributeMaxDynamicSharedMemorySize, LDS_BYTES) != hipSuccess) { fprintf(stderr, "kernel_launch: hipFuncSetAttribute failed\n"); grid = -1; return; }
        if (hipOccupancyMaxActiveBlocksPerMultiprocessor(&per_cu, (const void*)mega_fwd, NWAVES * 64, LDS_BYTES) != hipSuccess || per_cu < 1) fprintf(stderr, "kernel_launch: occupancy query reports %d\n", per_cu);
        (void)hipGetLastError();
        grid = cus;
    }
    if (grid < 0) return;
    if (hipMemsetAsync((char*)d_ws + WS_CTL, 0, CTL_ZERO_BYTES, stream) != hipSuccess) { fprintf(stderr, "kernel_launch: memset failed\n"); return; }
    Args a{};
    for (int i = 0; i < 20; ++i) a.in[i] = (const float*)d_in[i];
    a.out = (float*)d_out; a.ws = (unsigned char*)d_ws;
#if MK_PER_PHASE
    for (int p = 0; p < 12; ++p) { a.ph_lo = p; a.ph_hi = p + 1; hipLaunchKernelGGL(mega_fwd, dim3(grid), dim3(NWAVES * 64), LDS_BYTES, stream, a); }
#else
    a.ph_lo = 0; a.ph_hi = 12; hipLaunchKernelGGL(mega_fwd, dim3(grid), dim3(NWAVES * 64), LDS_BYTES, stream, a);
#endif
}
```

```cpp
#include <hip/hip_runtime.h>
#include <cstdio>
#include <cstdint>
#include <cmath>
namespace pg8 {
#define PG8_LAS __attribute__((address_space(3)))
typedef unsigned short bf16_t;
typedef short bf16x8 __attribute__((ext_vector_type(8)));
typedef float f32x4 __attribute__((ext_vector_type(4)));
typedef unsigned u32x4 __attribute__((ext_vector_type(4)));
constexpr int BM = 256, BK = 64, HALF = 128, HTB = HALF * BK * 2  , STAGE_BYTES = 8 * HTB, NXCD = 8, WGM = 8;

__host__ __device__ __forceinline__ int lds_byte(int r, int c) { const int st = (r >> 4) * 2 + (c >> 5), rr = r & 15, cc = c & 31, ob = rr * 64 + cc * 2; return st * 1024 + (ob ^ (((ob >> 9) & 1) << 5)); }
__host__ __device__ __forceinline__ void stage_rc(int b, int& R, int& C) { const int st = b / 1024, sb = b % 1024, swz = sb ^ (((sb >> 9) & 1) << 5); R = (st >> 1) * 16 + swz / 64; C = (st & 1) * 32 + (swz % 64) / 2; }
__host__ __device__ __forceinline__ int perm32(int rho) { const int n = rho >> 4, i = rho & 15; return 8 * (i >> 2) + 4 * n + (i & 3); }

struct Unit { int pm, pn; };
struct Gemm { const bf16_t* A; const bf16_t* Bt; int M, N, K; };

struct StaticOrder {
    int nM, nN, nwg, G, c;
    __host__ __device__ void init(int M, int N, int G_, int c_) { nM = M / BM; nN = N / BM; nwg = nM * nN; G = G_; c = c_; }
    __host__ __device__ bool next(int i, Unit& u) const {
        const long L = (long)i * G + c; if (L >= nwg) return false;
        int wgid = (int)L; { const int q = nwg / NXCD, r = nwg % NXCD, xcd = wgid % NXCD, off = wgid / NXCD; wgid = (xcd < r ? xcd * (q + 1) : r * (q + 1) + (xcd - r) * q) + off; }
        const int nig = WGM * nN, gid = wgid / nig, fm = gid * WGM, gsz = (nM - fm) < WGM ? (nM - fm) : WGM;
        u.pm = fm + ((wgid % nig) % gsz); u.pn = (wgid % nig) / gsz; return true;
    }
    __device__ __forceinline__ void a_ready(const Unit&) const {}
    __device__ __forceinline__ void done(const Unit&) const {}
};

__device__ __forceinline__ unsigned cvt_pk_bf16(float lo, float hi) { unsigned r; asm volatile("v_cvt_pk_bf16_f32 %0, %1, %2" : "=v"(r) : "v"(lo), "v"(hi)); return r; }

typedef float f32x2 __attribute__((ext_vector_type(2)));
typedef unsigned u32x2 __attribute__((ext_vector_type(2)));
__device__ __forceinline__ float bf_lo(unsigned w) { return __builtin_bit_cast(float, w << 16); }
__device__ __forceinline__ float bf_hi(unsigned w) { return __builtin_bit_cast(float, w & 0xffff0000u); }
__device__ __forceinline__ float sigmoid_f(float v) { return __builtin_amdgcn_rcpf(1.0f + __expf(-v)); }
__device__ __forceinline__ float sig2(float vp) { return __builtin_amdgcn_rcpf(1.0f + __builtin_amdgcn_exp2f(vp)); }
__device__ __forceinline__ unsigned pk_f16(float lo, float hi) { const _Float16 a = (_Float16)lo, b = (_Float16)hi; return (unsigned)__builtin_bit_cast(unsigned short, a) | ((unsigned)__builtin_bit_cast(unsigned short, b) << 16); }

template <int MODE> __device__ __forceinline__ u32x4 pack8(f32x4 v0, f32x4 v1, f32x4 l0, f32x4 l1) {
    u32x4 w;
    if (MODE == 0) { w.x = cvt_pk_bf16(v0[0], v0[1]); w.y = cvt_pk_bf16(v0[2], v0[3]); w.z = cvt_pk_bf16(v1[0], v1[1]); w.w = cvt_pk_bf16(v1[2], v1[3]); }
    else {
        f32x4 e0, e1, s0, s1;
#pragma unroll
        for (int e = 0; e < 4; ++e) { e0[e] = __builtin_amdgcn_exp2f(v0[e]); e1[e] = __builtin_amdgcn_exp2f(v1[e]); }
        const f32x4 d0 = e0 + 1.0f, d1 = e1 + 1.0f;
#pragma unroll
        for (int e = 0; e < 4; ++e) { s0[e] = __builtin_amdgcn_rcpf(d0[e]); s1[e] = __builtin_amdgcn_rcpf(d1[e]); }
        if (MODE == 2) { const f32x4 f0 = l0 + (1.0f - l0) * s0, f1 = l1 + (1.0f - l1) * s1; float r[8];
#pragma unroll
            for (int e = 0; e < 4; ++e) { r[e] = __log2f(f0[e]); r[4 + e] = __log2f(f1[e]); }
            w.x = pk_f16(r[0], r[1]); w.y = pk_f16(r[2], r[3]); w.z = pk_f16(r[4], r[5]); w.w = pk_f16(r[6], r[7]);
        } else { f32x4 r0, r1;
            if (MODE == 1) { r0 = (v0 * (-0.6931471805599453f * 0.08838834764831845f)) * s0; r1 = (v1 * (-0.6931471805599453f * 0.08838834764831845f)) * s1; }
            else if (MODE == 3) { r0 = (v0 * -0.6931471805599453f) * s0; r1 = (v1 * -0.6931471805599453f) * s1; }
            else { r0 = __builtin_elementwise_max(s0, (f32x4){1e-20f, 1e-20f, 1e-20f, 1e-20f}); r1 = __builtin_elementwise_max(s1, (f32x4){1e-20f, 1e-20f, 1e-20f, 1e-20f}); }
            w.x = cvt_pk_bf16(r0[0], r0[1]); w.y = cvt_pk_bf16(r0[2], r0[3]); w.z = cvt_pk_bf16(r1[0], r1[1]); w.w = cvt_pk_bf16(r1[2], r1[3]); }
    }
    return w;
}
template <int MODE> __device__ __forceinline__ void store_tile(const f32x4 (&acc)[2][2][4][2], bf16_t* base, int ldc, int row0, int col0, const float* lb) {
    f32x4 l[2][2];
#pragma unroll
    for (int bj = 0; bj < 2; ++bj)
#pragma unroll
        for (int n = 0; n < 2; ++n) l[bj][n] = (MODE == 2) ? *(const f32x4*)(lb + col0 + bj * HALF + 4 * n) : (f32x4){0.f, 0.f, 0.f, 0.f};
#pragma unroll
    for (int ai = 0; ai < 2; ++ai)
#pragma unroll
        for (int m = 0; m < 4; ++m) { bf16_t* rowp = base + (size_t)(row0 + ai * HALF + m * 16) * ldc + col0;
#pragma unroll
            for (int bj = 0; bj < 2; ++bj) *(u32x4*)(rowp + bj * HALF) = pack8<MODE>(acc[ai][bj][m][0], acc[ai][bj][m][1], l[bj][0], l[bj][1]);
            asm volatile("" ::: "memory"); }
}

__device__ __forceinline__ void store_tile_norm(const f32x4 (&acc)[2][2][4][2], bf16_t* base, int ldc, int row0, int col0, const float* gain, float scale, PG8_LAS float* scr, int wr, int wc, int fr, int fq) {
#pragma unroll
    for (int ai = 0; ai < 2; ++ai)
#pragma unroll
        for (int m = 0; m < 4; ++m) { float s[2];
#pragma unroll
            for (int bj = 0; bj < 2; ++bj) { const f32x4 a = acc[ai][bj][m][0], b = acc[ai][bj][m][1], q = a * a + b * b;
                float t = (q[0] + q[1]) + (q[2] + q[3]);
                t += __shfl_xor(t, 16); t += __shfl_xor(t, 32); s[bj] = t; }
            if (fq == 0) { const int lr = ai * HALF + wr * 64 + m * 16 + fr; scr[(lr * 2 + 0) * 4 + wc] = s[0]; scr[(lr * 2 + 1) * 4 + wc] = s[1]; } }
    asm volatile("s_waitcnt lgkmcnt(0)" ::: "memory"); __builtin_amdgcn_s_barrier(); asm volatile("" ::: "memory");
    const f32x4 g0 = *(const f32x4*)(gain + wc * 32 + 8 * fq), g1 = *(const f32x4*)(gain + wc * 32 + 8 * fq + 4);
#pragma unroll
    for (int ai = 0; ai < 2; ++ai)
#pragma unroll
        for (int m = 0; m < 4; ++m) { const int lr = ai * HALF + wr * 64 + m * 16 + fr; bf16_t* rowp = base + (size_t)(row0 + ai * HALF + m * 16) * ldc + col0;
#pragma unroll
            for (int bj = 0; bj < 2; ++bj) { const f32x4 p = *(const PG8_LAS f32x4*)(scr + (lr * 2 + bj) * 4);
                const float rs = __builtin_amdgcn_rsqf(((p[0] + p[1]) + (p[2] + p[3])) * (1.0f / 128.0f) + 1e-6f) * scale;
                const f32x4 v0 = acc[ai][bj][m][0] * (g0 * rs), v1 = acc[ai][bj][m][1] * (g1 * rs); u32x4 w;
                w.x = cvt_pk_bf16(v0[0], v0[1]); w.y = cvt_pk_bf16(v0[2], v0[3]); w.z = cvt_pk_bf16(v1[0], v1[1]); w.w = cvt_pk_bf16(v1[2], v1[3]);
                *(u32x4*)(rowp + bj * HALF) = w; }
            asm volatile("" ::: "memory"); }
}

#ifndef GATE_RND
#define GATE_RND 0.0f
#endif
struct EpiProj {
    static constexpr bool PERM = true, AFTER_DRAIN = false, HAS_MID = false; static constexpr int MID0 = -1, MID1 = -1;
    unsigned char* ws; bf16_t* gates; const float* lb;
    const float *gq, *gk, *gmq; PG8_LAS float* scr;
    static constexpr float QSC = 0.08838834764831845f * 1.4426950408889634f;
    static constexpr size_t O_HGQ = 116ull << 20, O_LFF = 148ull << 20, O_LFB = 180ull << 20, O_HGV = 212ull << 20, O_HGG = 244ull << 20, O_DAQ = 276ull << 20, O_DAK = 324ull << 20, O_DAV = 372ull << 20, O_MQ = 420ull << 20;
    __device__ __forceinline__ void operator()(const f32x4 (&acc)[2][2][4][2], const Unit& u, int wr, int wc, int fr, int fq) const {
        const int pn = u.pn, row0 = u.pm * BM + wr * 64 + fr, cl = wc * 32 + 8 * fq;
        unsigned tw = 0u; const bool touch = !(pn >= 36 && pn < 40);
        if (touch) { const int pnn = pn + 4 >= 52 ? pn + 4 - 52 : pn + 4; tw = *(const unsigned*)(ws + (1ull << 20) + (size_t)pnn * 524288 + (size_t)(u.pm & 7) * 65536 + (size_t)(((wr * 4 + wc) * 64 + fq * 16 + fr) * 128)); }
        if (pn < 4)       store_tile<1>(acc, (bf16_t*)(ws + O_HGQ), 1024, row0, pn * 256 + cl, nullptr);
        else if (pn < 12) store_tile<2>(acc, (bf16_t*)(ws + (pn < 8 ? O_LFF : O_LFB)), 1024, row0, ((pn - 4) & 3) * 256 + cl, lb + (pn < 8 ? 0 : 1024));
        else if (pn < 20) { if (pn < 16) store_tile<0>(acc, (bf16_t*)(ws + O_HGV), 1024, row0, (pn - 12) * 256 + cl, nullptr); else store_tile<3>(acc, (bf16_t*)(ws + O_HGG), 1024, row0, (pn - 16) * 256 + cl, nullptr); }
        else if (pn < 32) { const bool isq = pn < 26; const int c0 = isq ? pn - 20 : pn - 26;
            store_tile_norm(acc, (bf16_t*)(ws + (isq ? O_DAQ : O_DAK)), 1536, row0, c0 * 256 + cl, isq ? gq : gk, isq ? QSC : 1.0f, scr, wr, wc, fr, fq); }
        else if (pn < 38) store_tile<0>(acc, (bf16_t*)(ws + O_DAV), 1536, row0, (pn - 32) * 256 + cl, nullptr);
        else if (pn < 40) store_tile_norm(acc, (bf16_t*)(ws + O_MQ), 512, row0, (pn - 38) * 256 + cl, gmq, QSC, scr, wr, wc, fr, fq);
        else {
            unsigned char* gt = (unsigned char*)gates + ((size_t)(((pn - 40) >> 2) * 64 + u.pm) * 4 + ((pn - 40) & 3)) * 65536 + (size_t)((wr * 4 + wc) * 16) * 512 + (fq * 16 + fr) * 8;
#pragma unroll
            for (int ai = 0; ai < 2; ++ai)
#pragma unroll
                for (int m = 0; m < 4; ++m) {
#pragma unroll
                    for (int bj = 0; bj < 2; ++bj) { u32x2 w = {0u, 0u};
#pragma unroll
                        for (int e = 0; e < 4; ++e) {
                            const float r0 = fmaxf(__builtin_amdgcn_rcpf(__builtin_fmaf(__builtin_amdgcn_exp2f(acc[ai][bj][m][0][e]), 1.0f / 255.0f, 1.0f / 255.0f)), 1.0f) + GATE_RND;
                            const float r1 = fmaxf(__builtin_amdgcn_rcpf(__builtin_fmaf(__builtin_amdgcn_exp2f(acc[ai][bj][m][1][e]), 1.0f / 255.0f, 1.0f / 255.0f)), 1.0f) + GATE_RND;
                            w.x = __builtin_amdgcn_cvt_pk_u8_f32(r0, e, w.x); w.y = __builtin_amdgcn_cvt_pk_u8_f32(r1, e, w.y); }
                        *(u32x2*)(gt + ((ai * 4 + m) * 2 + bj) * 512) = w; }
                    asm volatile("" ::: "memory"); } }
        if (touch && tw == 0x9e3779b9u) *(unsigned*)(ws + 8192) = tw;
    }
};
struct EpiKV {
    static constexpr bool PERM = true, AFTER_DRAIN = false, HAS_MID = false; static constexpr int MID0 = -1, MID1 = -1;
    bf16_t* O; const float* gk; PG8_LAS float* scr;
    __device__ __forceinline__ void operator()(const f32x4 (&acc)[2][2][4][2], const Unit& u, int wr, int wc, int fr, int fq) const {
        const int row0 = u.pm * BM + wr * 64 + fr, col0 = u.pn * 256 + wc * 32 + 8 * fq;
        if (u.pn < 2) store_tile_norm(acc, O, 1024, row0, col0, gk, 1.0f, scr, wr, wc, fr, fq);
        else          store_tile<0>(acc, O, 1024, row0, col0, nullptr);
    }
};
struct EpiMerged {
    static constexpr bool PERM = true, AFTER_DRAIN = false, HAS_MID = true; static constexpr int MID0 = 16, MID1 = 24;
    const bf16_t* gates; bf16_t* O; int row_off;
    static __device__ __forceinline__ float ub(unsigned w, int i) { return (float)((w >> (8 * i)) & 0xffu); }
    __device__ __forceinline__ void mid(f32x4 (&acc)[2][2][4][2], const Unit& u, int t, int wr, int wc, int fr, int fq) const {
        int wv = wr * 4 + wc, ln = fq * 16 + fr;
        asm volatile("" : "+v"(ln));
        const unsigned char* gp0 = (const unsigned char*)gates + ((size_t)((t == MID0 ? 0 : 1) * 64 + u.pm) * 4 + u.pn) * 65536 + (size_t)(wv * 16) * 512 + ln * 8;
#pragma unroll
        for (int ai = 0; ai < 2; ++ai)
#pragma unroll
            for (int m = 0; m < 4; ++m) {
#pragma unroll
                for (int bj = 0; bj < 2; ++bj) { const unsigned char* gp = gp0 + ((ai * 4 + m) * 2 + bj) * 512; const u32x2 a = *(const u32x2*)gp, b = *(const u32x2*)(gp + (size_t)64 * 4 * 65536);
                    f32x4 r0, r1;
#pragma unroll
                    for (int e = 0; e < 4; ++e) { r0[e] = ub(a.x, e) * __builtin_amdgcn_rcpf(ub(b.x, e)); r1[e] = ub(a.y, e) * __builtin_amdgcn_rcpf(ub(b.y, e)); }
                    acc[ai][bj][m][0] *= r0; acc[ai][bj][m][1] *= r1; }
                if (m == 3) asm volatile("" ::: "memory"); }
    }
    __device__ __forceinline__ void operator()(const f32x4 (&acc)[2][2][4][2], const Unit& u, int wr, int wc, int fr, int fq) const {
        const int row0 = u.pm * BM + wr * 64 + fr, col0 = u.pn * BM + wc * 32 + 8 * fq;
        const unsigned char* gp0 = (const unsigned char*)gates + ((size_t)(2 * 64 + u.pm) * 4 + u.pn) * 65536 + (size_t)((wr * 4 + wc) * 16) * 512 + (fq * 16 + fr) * 8;
#pragma unroll
        for (int ai = 0; ai < 2; ++ai)
#pragma unroll
            for (int m = 0; m < 4; ++m) { const int r = row0 + ai * HALF + m * 16; bf16_t* op = O + (size_t)(row_off + r) * 1024 + col0;
#pragma unroll
                for (int bj = 0; bj < 2; ++bj) { const u32x2 g = *(const u32x2*)(gp0 + ((ai * 4 + m) * 2 + bj) * 512); const f32x4 v0 = acc[ai][bj][m][0] * (1.0f / 255.0f), v1 = acc[ai][bj][m][1] * (1.0f / 255.0f); u32x4 w;
                    w.x = cvt_pk_bf16(v0[0] * ub(g.x, 0), v0[1] * ub(g.x, 1)); w.y = cvt_pk_bf16(v0[2] * ub(g.x, 2), v0[3] * ub(g.x, 3));
                    w.z = cvt_pk_bf16(v1[0] * ub(g.y, 0), v1[1] * ub(g.y, 1)); w.w = cvt_pk_bf16(v1[2] * ub(g.y, 2), v1[3] * ub(g.y, 3));
                    *(u32x4*)(op + bj * HALF) = w; } }
    }
};
struct EpiWout {
    static constexpr bool PERM = false, AFTER_DRAIN = false, HAS_MID = false; static constexpr int MID0 = -1, MID1 = -1;
    const float* x; bf16_t* x1b; float* ssq;
    __device__ __forceinline__ void operator()(const f32x4 (&acc)[2][2][4][2], const Unit& u, int wr, int wc, int fr, int fq) const {
        const int row0 = u.pm * BM + wr * 64 + fr, col0 = u.pn * BM + wc * 32 + 4 * fq;
#pragma unroll
        for (int ai = 0; ai < 2; ++ai)
#pragma unroll
            for (int m = 0; m < 4; ++m) { const int r = row0 + ai * HALF + m * 16; const size_t off = (size_t)r * 1024 + col0; float s = 0.f;
#pragma unroll
                for (int bj = 0; bj < 2; ++bj)
#pragma unroll
                    for (int n = 0; n < 2; ++n) { const f32x4 v = *(const f32x4*)(x + off + bj * HALF + n * 16) + acc[ai][bj][m][n];
                        u32x2 w; w.x = cvt_pk_bf16(v[0], v[1]); w.y = cvt_pk_bf16(v[2], v[3]); *(u32x2*)(x1b + off + bj * HALF + n * 16) = w;
                        s += (v[0] * v[0] + v[1] * v[1]) + (v[2] * v[2] + v[3] * v[3]); }
                s += __shfl_xor(s, 16); s += __shfl_xor(s, 32);
                if (fq == 0) ssq[(size_t)r * 16 + u.pn * 4 + wc] = s; }
    }
};
struct EpiFfnIn {
    static constexpr bool PERM = true, AFTER_DRAIN = false, HAS_MID = false; static constexpr int MID0 = -1, MID1 = -1;
    const float* ssq; bf16_t* U;
    PG8_LAS float* cache;
    __device__ __forceinline__ void operator()(const f32x4 (&acc)[2][2][4][2], const Unit& u, int wr, int wc, int fr, int fq) const {
        const int row0 = u.pm * BM + wr * 64 + fr, col0 = u.pn * 128 + wc * 32 + 8 * fq;
        PG8_LAS float* cw = cache + (wr * 4 + wc) * 132;
        float rsv[2][4];
        if (__builtin_amdgcn_readfirstlane(((volatile PG8_LAS int*)cw)[128]) != u.pm + 1) {
#pragma unroll
            for (int ai = 0; ai < 2; ++ai)
#pragma unroll
                for (int m = 0; m < 4; ++m) { const int r = row0 + ai * HALF + m * 16; const f32x4* sp = (const f32x4*)(ssq + (size_t)r * 16);
                    const f32x4 s4 = (sp[0] + sp[1]) + (sp[2] + sp[3]); rsv[ai][m] = __builtin_amdgcn_rsqf(((s4[0] + s4[1]) + (s4[2] + s4[3])) * (1.0f / 1024.0f) + 1e-6f);
                    if (fq == 0) cw[(ai * 4 + m) * 16 + fr] = rsv[ai][m]; }
            if (fq == 0 && fr == 0) ((volatile PG8_LAS int*)cw)[128] = u.pm + 1;
        } else {
#pragma unroll
            for (int ai = 0; ai < 2; ++ai)
#pragma unroll
                for (int m = 0; m < 4; ++m) rsv[ai][m] = cw[(ai * 4 + m) * 16 + fr];
        }
#pragma unroll
        for (int ai = 0; ai < 2; ++ai)
#pragma unroll
            for (int m = 0; m < 4; ++m) { const int r = row0 + ai * HALF + m * 16; const float rs = rsv[ai][m], nrs = rs * -1.4426950408889634f, rs2 = rs * rs;
                f32x4 o[2];
#pragma unroll
                for (int n = 0; n < 2; ++n) { const f32x4 t = acc[ai][0][m][n] * nrs, p = acc[ai][0][m][n] * acc[ai][1][m][n]; f32x4 ex, rc;
#pragma unroll
                    for (int e = 0; e < 4; ++e) ex[e] = __builtin_amdgcn_exp2f(t[e]);
                    const f32x4 d = ex + 1.0f;
#pragma unroll
                    for (int e = 0; e < 4; ++e) rc[e] = __builtin_amdgcn_rcpf(d[e]);
                    o[n] = p * (rc * rs2); }
                u32x4 w; w.x = cvt_pk_bf16(o[0][0], o[0][1]); w.y = cvt_pk_bf16(o[0][2], o[0][3]); w.z = cvt_pk_bf16(o[1][0], o[1][1]); w.w = cvt_pk_bf16(o[1][2], o[1][3]);
                *(u32x4*)(U + (size_t)r * 2816 + col0) = w; }
    }
};
struct EpiFfnOut {
    static constexpr bool PERM = false, AFTER_DRAIN = false, HAS_MID = false; static constexpr int MID0 = -1, MID1 = -1;
    const bf16_t* x1b; float* out;
    __device__ __forceinline__ void operator()(const f32x4 (&acc)[2][2][4][2], const Unit& u, int wr, int wc, int fr, int fq) const {
        const int row0 = u.pm * BM + wr * 64 + fr, col0 = u.pn * BM + wc * 32 + 4 * fq;
#pragma unroll
        for (int ai = 0; ai < 2; ++ai)
#pragma unroll
            for (int m = 0; m < 4; ++m) { const size_t off = (size_t)(row0 + ai * HALF + m * 16) * 1024 + col0;
#pragma unroll
                for (int bj = 0; bj < 2; ++bj)
#pragma unroll
                    for (int n = 0; n < 2; ++n) { const u32x2 w = *(const u32x2*)(x1b + off + bj * HALF + n * 16); f32x4 v; v[0] = bf_lo(w.x); v[1] = bf_hi(w.x); v[2] = bf_lo(w.y); v[3] = bf_hi(w.y);
                        *(f32x4*)(out + off + bj * HALF + n * 16) = v + acc[ai][bj][m][n]; } }
    }
};
template <class Epi, class Sched, bool ALIGN_EPI = false, bool SP2 = false>
__device__ __forceinline__ void gemm_phase(PG8_LAS unsigned char* lds, const Gemm g, const Sched& S, const Epi& E, int tid_in) {
    int tid_ = tid_in; asm volatile("" : "+v"(tid_));
    const int tid = tid_, wid = __builtin_amdgcn_readfirstlane(tid >> 6), lane = tid & 63, wr = wid >> 2, wc = wid & 3, fr = lane & 15, fq = lane >> 4;
    const int K = g.K, nt = K / BK;
    unsigned voffA[2], voffB[2];
#pragma unroll
    for (int i = 0; i < 2; ++i) { int R, C; stage_rc(tid * 16 + i * 8192, R, C); const int Rb = Epi::PERM ? ((R & ~31) + perm32(R & 31)) : R;
        voffA[i] = (unsigned)(R * K + C) * 2u; voffB[i] = (unsigned)(Rb * K + C) * 2u; }
    const size_t kstep = (size_t)(BK * 2);
    const size_t hstep = (size_t)HALF * K * 2;
    const size_t tstep = 2 * hstep;
    const unsigned ldsw = (unsigned)wid * 1024u;
    const int aoff = lds_byte(wr * 64 + fr, fq * 8), boff = lds_byte(wc * 32 + fr, fq * 8);
#define PG8_SA(b, h) (((b) * 2 + (h)) * HTB)
#define PG8_SB(b, h) ((4 + (b) * 2 + (h)) * HTB)
#define PG8_STAGE(bufoff, gbase, voff) do { _Pragma("unroll") for (int _i = 0; _i < 2; ++_i) \
        __builtin_amdgcn_global_load_lds((const unsigned*)((const char*)(gbase) + (voff)[_i]), (PG8_LAS unsigned*)(lds + (bufoff) + ldsw + _i * 8192), 16, 0, 0); } while (0)
#define PG8_LDA(dst, b, h) do { _Pragma("unroll") for (int m = 0; m < 4; ++m) _Pragma("unroll") for (int k = 0; k < 2; ++k) dst[m][k] = *(const PG8_LAS bf16x8*)(lds + PG8_SA(b, h) + aoff + m * 2048 + k * 1024); } while (0)
#define PG8_LDB(dst, b, h) do { _Pragma("unroll") for (int n = 0; n < 2; ++n) _Pragma("unroll") for (int k = 0; k < 2; ++k) dst[n][k] = *(const PG8_LAS bf16x8*)(lds + PG8_SB(b, h) + boff + n * 2048 + k * 1024); } while (0)
#define PG8_MMA(ai, bj, At, Bt) do { __builtin_amdgcn_s_setprio(1); _Pragma("unroll") for (int m = 0; m < 4; ++m) _Pragma("unroll") for (int n = 0; n < 2; ++n) _Pragma("unroll") for (int k = 0; k < 2; ++k) \
        acc[ai][bj][m][n] = __builtin_amdgcn_mfma_f32_16x16x32_bf16(Bt[n][k], At[m][k], acc[ai][bj][m][n], 0, 0, 0); __builtin_amdgcn_s_setprio(0); } while (0)
#define PG8_WAIT_V(n) asm volatile("s_waitcnt vmcnt(" #n ")" ::: "memory")
#define PG8_WAIT_L(n) asm volatile("s_waitcnt lgkmcnt(" #n ")" ::: "memory")
#define PG8_BAR __builtin_amdgcn_s_barrier()
#define PG8_SCHED __builtin_amdgcn_sched_barrier(0)
    Unit cur, nxt; int ui = 0;
    if (!S.next(0, cur)) return;
    f32x4 acc[2][2][4][2];
#pragma unroll
    for (int a = 0; a < 2; ++a)
#pragma unroll
        for (int b = 0; b < 2; ++b)
#pragma unroll
            for (int m = 0; m < 4; ++m)
#pragma unroll
                for (int n = 0; n < 2; ++n) acc[a][b][m][n] = (f32x4){0.f, 0.f, 0.f, 0.f};
    bf16x8 At[4][2], B0[2][2], B1[2][2];
    const char* cA = (const char*)g.A + (size_t)cur.pm * tstep; const char* cB = (const char*)g.Bt + (size_t)cur.pn * tstep;
    S.a_ready(cur);
    if constexpr (SP2) {
        PG8_STAGE(PG8_SB(0, 0), cB, voffB); PG8_STAGE(PG8_SB(0, 1), cB + hstep, voffB); PG8_STAGE(PG8_SA(0, 0), cA, voffA); PG8_STAGE(PG8_SA(0, 1), cA + hstep, voffA);
        if (wr == 1) PG8_BAR;
        PG8_WAIT_V(2); PG8_BAR;
        PG8_STAGE(PG8_SB(1, 0), cB + kstep, voffB); PG8_STAGE(PG8_SA(1, 0), cA + kstep, voffA); PG8_STAGE(PG8_SB(1, 1), cB + hstep + kstep, voffB);
        PG8_WAIT_V(6); PG8_BAR;
    } else {
        PG8_STAGE(PG8_SB(0, 0), cB, voffB); PG8_STAGE(PG8_SA(0, 0), cA, voffA); PG8_STAGE(PG8_SB(0, 1), cB + hstep, voffB); PG8_STAGE(PG8_SA(0, 1), cA + hstep, voffA);
        if (wr == 1) PG8_BAR;
        PG8_WAIT_V(4); PG8_BAR;
        PG8_STAGE(PG8_SB(1, 0), cB + kstep, voffB); PG8_STAGE(PG8_SA(1, 0), cA + kstep, voffA); PG8_STAGE(PG8_SB(1, 1), cB + hstep + kstep, voffB);
        PG8_WAIT_V(6); PG8_BAR;
    }
    for (;;) {
        const bool has_next = S.next(ui + 1, nxt);
        const char* nA = has_next ? (const char*)g.A + (size_t)nxt.pm * tstep : cA; const char* nB = has_next ? (const char*)g.Bt + (size_t)nxt.pn * tstep : cB;
        for (int t = 0; t < nt; t += 2) {
            if constexpr (Epi::HAS_MID) { if (t == Epi::MID0 || t == Epi::MID1) E.mid(acc, cur, t, wr, wc, fr, fq); }
            const bool last = (t == nt - 2);
            const char* a1 = cA + (size_t)(t + 1) * kstep;
            const char* a2 = last ? nA : cA + (size_t)(t + 2) * kstep; const char* b2 = last ? nB : cB + (size_t)(t + 2) * kstep;
            const char* a3 = a2 + kstep; const char* b3 = b2 + kstep;
            if (last && has_next) S.a_ready(nxt);
            if constexpr (SP2) {
            PG8_LDB(B0, 0, 0); PG8_LDB(B1, 0, 1); PG8_SCHED; PG8_LDA(At, 0, 0); PG8_STAGE(PG8_SA(1, 1), a1 + hstep, voffA);
            PG8_WAIT_V(8); PG8_WAIT_L(0); PG8_BAR; PG8_MMA(0, 0, At, B0); PG8_MMA(0, 1, At, B1); PG8_BAR; PG8_SCHED;
            PG8_LDA(At, 0, 1); PG8_STAGE(PG8_SB(0, 0), b2, voffB); PG8_STAGE(PG8_SB(0, 1), b2 + hstep, voffB); PG8_STAGE(PG8_SA(0, 0), a2, voffA);
            PG8_WAIT_V(8); PG8_WAIT_L(0); PG8_BAR; PG8_MMA(1, 0, At, B0); PG8_MMA(1, 1, At, B1); PG8_BAR; PG8_SCHED;
            PG8_LDB(B0, 1, 0); PG8_LDB(B1, 1, 1); PG8_SCHED; PG8_LDA(At, 1, 0); PG8_STAGE(PG8_SA(0, 1), a2 + hstep, voffA);
            PG8_WAIT_V(8); PG8_WAIT_L(0); PG8_BAR; PG8_MMA(0, 0, At, B0); PG8_MMA(0, 1, At, B1); PG8_BAR; PG8_SCHED;
            PG8_LDA(At, 1, 1); PG8_STAGE(PG8_SB(1, 0), b3, voffB); PG8_STAGE(PG8_SB(1, 1), b3 + hstep, voffB); PG8_STAGE(PG8_SA(1, 0), a3, voffA);
            PG8_WAIT_V(8); PG8_WAIT_L(0); PG8_BAR; PG8_MMA(1, 0, At, B0); PG8_MMA(1, 1, At, B1); PG8_BAR; PG8_SCHED;
            } else {
            PG8_LDB(B0, 0, 0); PG8_SCHED; PG8_LDA(At, 0, 0); PG8_STAGE(PG8_SA(1, 1), a1 + hstep, voffA);
            PG8_WAIT_L(8); PG8_BAR; PG8_WAIT_L(0); PG8_MMA(0, 0, At, B0); PG8_BAR; PG8_SCHED;
            PG8_LDB(B1, 0, 1); PG8_STAGE(PG8_SB(0, 0), b2, voffB);
            PG8_BAR; PG8_WAIT_L(0); PG8_MMA(0, 1, At, B1); PG8_BAR;
            PG8_LDA(At, 0, 1); PG8_STAGE(PG8_SA(0, 0), a2, voffA);
            PG8_BAR; PG8_WAIT_L(0); PG8_MMA(1, 0, At, B0); PG8_BAR; PG8_SCHED;
            PG8_STAGE(PG8_SB(0, 1), b2 + hstep, voffB);
            PG8_WAIT_V(6); PG8_BAR; PG8_MMA(1, 1, At, B1); PG8_BAR;
            PG8_LDB(B0, 1, 0); PG8_SCHED; PG8_LDA(At, 1, 0); PG8_STAGE(PG8_SA(0, 1), a2 + hstep, voffA);
            PG8_WAIT_L(8); PG8_BAR; PG8_WAIT_L(0); PG8_MMA(0, 0, At, B0); PG8_BAR; PG8_SCHED;
            PG8_LDB(B1, 1, 1); PG8_STAGE(PG8_SB(1, 0), b3, voffB);
            PG8_BAR; PG8_WAIT_L(0); PG8_MMA(0, 1, At, B1); PG8_BAR;
            PG8_LDA(At, 1, 1); PG8_STAGE(PG8_SA(1, 0), a3, voffA);
            PG8_BAR; PG8_WAIT_L(0); PG8_MMA(1, 0, At, B0); PG8_BAR; PG8_SCHED;
            PG8_STAGE(PG8_SB(1, 1), b3 + hstep, voffB);
            PG8_WAIT_V(6); PG8_BAR; PG8_MMA(1, 1, At, B1); PG8_BAR;
            }
        }
        if constexpr (ALIGN_EPI) { if (wr == 0) PG8_BAR; }
        if constexpr (!Epi::AFTER_DRAIN) { E(acc, cur, wr, wc, fr, fq); S.done(cur); }
        if (!has_next) break;
#pragma unroll
        for (int a = 0; a < 2; ++a)
#pragma unroll
            for (int b = 0; b < 2; ++b)
#pragma unroll
                for (int m = 0; m < 4; ++m)
#pragma unroll
                    for (int n = 0; n < 2; ++n) acc[a][b][m][n] = (f32x4){0.f, 0.f, 0.f, 0.f};
        cur = nxt; cA = nA; cB = nB; ++ui;
        if constexpr (ALIGN_EPI) { if (wr == 1) PG8_BAR; }
    }
    PG8_WAIT_V(0);
    if constexpr (!ALIGN_EPI) { if (wr == 0) PG8_BAR; }
    PG8_BAR;
    if constexpr (Epi::AFTER_DRAIN) { E.fused(acc, cur, wr, wc, fr, fq, lds, wid, lane); S.done(cur); }
#undef PG8_SA
#undef PG8_SB
#undef PG8_STAGE
#undef PG8_LDA
#undef PG8_LDB
#undef PG8_MMA
#undef PG8_WAIT_V
#undef PG8_WAIT_L
#undef PG8_BAR
#undef PG8_SCHED
}
}

constexpr int NWAVES = 8;
constexpr int D = 1024, BATCH = 8, SEQ = 4096, MTOK = BATCH * SEQ;
constexpr int NGRP = 2, GB = BATCH / NGRP, GR = GB * SEQ;
constexpr int NMEM = 256, INC = 13312, DFF = 2816;
constexpr float RMS_EPS = 1e-6f;
constexpr float ATT_SCALE = 0.08838834764831845f;

constexpr size_t MiB = 1u << 20;
constexpr size_t WS_CTL = 0, CTL_ZERO_BYTES = 1 * MiB;
constexpr size_t WS_WIN = 1 * MiB, WS_WFI = 27 * MiB, WS_WFO = 38 * MiB, WS_WPC = 44 * MiB, WS_WO = 48 * MiB, WS_WKV = 50 * MiB;
constexpr size_t WS_H = 52 * MiB;
constexpr size_t WS_HGQ = 116 * MiB, WS_LFF = 148 * MiB, WS_LFB = 180 * MiB, WS_HGV = 212 * MiB, WS_HGG = 244 * MiB;
constexpr size_t WS_DAQ = 276 * MiB, WS_DAK = 324 * MiB, WS_DAV = 372 * MiB;
constexpr size_t WS_MQ = 420 * MiB;
constexpr size_t WS_OCAT = 436 * MiB;
constexpr size_t WS_MEMKV = 500 * MiB;
constexpr size_t WS_MEMN = 504 * MiB;
constexpr size_t WS_LB = 508 * MiB;
constexpr size_t WS_SSQ = 509 * MiB;
constexpr size_t WS_END = 512 * MiB;
constexpr size_t WS_X1B = 116 * MiB;
constexpr size_t WS_U = 180 * MiB;
constexpr size_t OUT_GATES = 0, OUT_SL = 96 * MiB;
constexpr size_t WS_LSE = 508 * MiB + 65536;
constexpr size_t WS_DT = 511 * MiB;
constexpr int CW_BAR = 4096;
static_assert(pg8::EpiProj::O_HGQ == WS_HGQ && pg8::EpiProj::O_LFF == WS_LFF && pg8::EpiProj::O_LFB == WS_LFB && pg8::EpiProj::O_HGV == WS_HGV && pg8::EpiProj::O_HGG == WS_HGG && pg8::EpiProj::O_DAQ == WS_DAQ && pg8::EpiProj::O_DAK == WS_DAK && pg8::EpiProj::O_DAV == WS_DAV && pg8::EpiProj::O_MQ == WS_MQ, "EpiProj offsets");

constexpr int RING_OFF = 0, RING_BYTES = 131072;
constexpr int LDSCTL_OFF = RING_BYTES, MISC_OFF = LDSCTL_OFF + 320;
constexpr int LDS_BYTES = 147456;
constexpr int EPI_SCR_OFF = RING_BYTES + 1024;
static_assert(EPI_SCR_OFF + 8192 <= LDS_BYTES, "LDS map");
#define GAS __attribute__((address_space(1)))
#define LAS __attribute__((address_space(3)))
typedef unsigned short bf16;
typedef unsigned v4u __attribute__((ext_vector_type(4)));
typedef float f32x4 __attribute__((ext_vector_type(4)));
typedef short bf16x8 __attribute__((ext_vector_type(8)));
typedef GAS unsigned gu32;
typedef GAS unsigned long long gu64;
#define RLX_AGENT __ATOMIC_RELAXED, __HIP_MEMORY_SCOPE_AGENT
#define LDS_WAIT() asm volatile("s_waitcnt lgkmcnt(0)" ::: "memory")
#define VM_WAIT() asm volatile("s_waitcnt vmcnt(0)" ::: "memory")
__device__ __forceinline__ unsigned long long rt() { return __builtin_amdgcn_s_memrealtime(); }
__device__ __forceinline__ unsigned f2bf(float f) { unsigned u = __builtin_bit_cast(unsigned, f); return (u + 0x7fffu + ((u >> 16) & 1u)) >> 16; }
__device__ __forceinline__ unsigned pk2(float lo, float hi) { return f2bf(lo) | (f2bf(hi) << 16); }

#define XB_TMO      128
#define XB_XCNT(j)  (256  + 64 * (j))
#define XB_XSUB(j)  (1280 + 64 * (j))
#define XB_XGEN(j)  (2304 + 64 * (j))
#define XB_TOP      3328
#define XB_TOPGEN   3392
#define XCD_BAR_WORDS 3456
#define XB_SPIN_CAP (1u << 18)

__device__ __forceinline__ unsigned xb_ld(unsigned* p)              { return __hip_atomic_load(p, __ATOMIC_RELAXED, __HIP_MEMORY_SCOPE_AGENT); }
__device__ __forceinline__ unsigned xb_add(unsigned* p, unsigned v) { return __hip_atomic_fetch_add(p, v, __ATOMIC_RELAXED, __HIP_MEMORY_SCOPE_AGENT); }
__device__ __forceinline__ unsigned xb_xcc_id() { return (unsigned)__builtin_amdgcn_s_getreg((3 << 11) | 20) & 0xFu; }
#define XB_SPIN(cond, bar) do { unsigned _sp = 0; while (cond) { __builtin_amdgcn_s_sleep(1); \
    if ((++_sp & 255u) == 0u) { if (xb_ld(&(bar)[XB_TMO])) break; if (_sp > XB_SPIN_CAP) { atomicAdd(&(bar)[XB_TMO], 1u); break; } } } } while (0)

struct XcdBarrier {
    unsigned* bar; unsigned x; int w0;
    volatile LAS unsigned* st;
};

__device__ __forceinline__ bool xb_t0(int w0) { unsigned z_ = 0u; asm volatile("" : "+v"(z_)); return w0 == 0 && __builtin_amdgcn_mbcnt_hi(~0u, __builtin_amdgcn_mbcnt_lo(~0u, z_)) == 0u; }
__device__ __forceinline__ XcdBarrier xcd_barrier_post(unsigned* bar, volatile LAS unsigned* st, int w0) {
    XcdBarrier b; b.bar = bar; b.x = xb_xcc_id(); b.st = st; b.w0 = w0;
    if (xb_t0(w0)) (void)xb_add(&bar[XB_XCNT(b.x)], 1u);
    return b;
}
__device__ __forceinline__ void xcd_barrier_complete(unsigned* bar, unsigned x, unsigned& nloc, unsigned& nx) {
    const unsigned G = gridDim.x * gridDim.y * gridDim.z;
    unsigned sum, cnt, mine, sp = 0u;
    for (;;) {
        sum = 0u; cnt = 0u; mine = 0u;
#pragma unroll
        for (unsigned j = 0; j < 16; ++j) { const unsigned c = xb_ld(&bar[XB_XCNT(j)]); sum += c; cnt += (c > 0u) ? 1u : 0u; mine = (j == x) ? c : mine; }
        if (sum == G) break;
        __builtin_amdgcn_s_sleep(1);
        if ((++sp & 255u) == 0u) { if (xb_ld(&bar[XB_TMO])) break; if (sp > XB_SPIN_CAP) { atomicAdd(&bar[XB_TMO], 1u); break; } }
    }
    nloc = mine > 0u ? mine : 1u; nx = cnt > 0u ? cnt : 1u;
}

struct XbNoFill { __device__ __forceinline__ void operator()() const {} };
template <class Fill = XbNoFill>
__device__ __forceinline__ void xcd_barrier(const XcdBarrier& b, const Fill& fill = Fill()) {
    asm volatile("s_waitcnt vmcnt(0)" ::: "memory");
    __syncthreads();
    if (xb_t0(b.w0)) {
        unsigned* bar = b.bar;
        __builtin_amdgcn_s_waitcnt(0);
        unsigned nloc = b.st[0], nx = b.st[1];
        if (nloc == 0u) { xcd_barrier_complete(bar, b.x, nloc, nx); b.st[0] = nloc; b.st[1] = nx; }
        const unsigned old = xb_add(&bar[XB_XSUB(b.x)], 1u);
        const unsigned gen = old / nloc;
        if (old + 1u == (gen + 1u) * nloc) {
            __builtin_amdgcn_fence(__ATOMIC_RELEASE, "agent");
            asm volatile("s_waitcnt vmcnt(0)" ::: "memory");
            const unsigned og = xb_add(&bar[XB_TOP], 1u);
            const unsigned tg = og / nx;
            if (og + 1u == (tg + 1u) * nx) xb_add(&bar[XB_TOPGEN], 1u);
            else XB_SPIN(xb_ld(&bar[XB_TOPGEN]) == tg, bar);
            __builtin_amdgcn_fence(__ATOMIC_ACQUIRE, "agent");
            xb_add(&bar[XB_XGEN(b.x)], 1u);
            asm volatile("s_waitcnt vmcnt(0)" ::: "memory");
        } else {
            XB_SPIN(xb_ld(&bar[XB_XGEN(b.x)]) == gen, bar);
            __builtin_amdgcn_fence(__ATOMIC_ACQUIRE, "agent");
            asm volatile("s_waitcnt vmcnt(0)" ::: "memory");
        }
    } else if (b.w0 != 0) { fill(); }
    __syncthreads();
}

#ifndef HG_PROBE
#define HG_PROBE 0
#endif
#ifndef MK_PER_PHASE
#define MK_PER_PHASE 0
#endif
#ifndef DEFER_T_ON
#define DEFER_T_ON 1
#endif
#ifndef DEFER_R_ON
#define DEFER_R_ON 1
#endif
constexpr bool DEFER_T = !MK_PER_PHASE && DEFER_T_ON, DEFER_R = !MK_PER_PHASE && DEFER_R_ON;
struct Args { const float* in[20]; float* out; unsigned char* ws; int ph_lo, ph_hi; };
struct Frame {
    LAS unsigned char* lds;
    volatile LAS unsigned* MISC;
    gu32* ctl;
    int tid, lane, wave, vcu, G;
};
__device__ __forceinline__ float wave_sum(float v) {
#pragma unroll
    for (int o = 1; o < 64; o <<= 1) v += __shfl_xor(v, o);
    return v;
}
__device__ __forceinline__ float wave_max(float v) {
#pragma unroll
    for (int o = 1; o < 64; o <<= 1) v = fmaxf(v, __shfl_xor(v, o));
    return v;
}
__device__ __forceinline__ float bf2f(unsigned short b) { return __builtin_bit_cast(float, (unsigned)b << 16); }
__device__ __forceinline__ float h2f(unsigned short b) { return (float)__builtin_bit_cast(_Float16, b); }
__device__ __forceinline__ float blo(unsigned w) { return __builtin_bit_cast(float, w << 16); }
__device__ __forceinline__ float bhi(unsigned w) { return __builtin_bit_cast(float, w & 0xffff0000u); }

struct P0Item { const float* W; int N; bf16* WT; int ldk, koff, k0, scol0, drow0; const float* ks; float cs; };
__device__ __forceinline__ void p0_item_load(const P0Item& d, float (&wv)[32], int lane) {
#pragma unroll
    for (int i = 0; i < 32; ++i) wv[i] = d.W[(size_t)(d.k0 + 2 * i + (lane >> 5)) * d.N + d.scol0 + (lane & 31)];
}
__device__ __forceinline__ void p0_item_finish(const P0Item& d, const float (&wv)[32], LAS float* scr, int lane) {
#pragma unroll
    for (int i = 0; i < 32; ++i) { const int kk = 2 * i + (lane >> 5); float v = wv[i] * d.cs; if (d.ks) v *= d.ks[d.k0 + kk]; scr[kk * 33 + (lane & 31)] = v; }
    LDS_WAIT(); asm volatile("" ::: "memory");
    const int c = lane & 7;
#pragma unroll
    for (int j = 0; j < 4; ++j) { const int n = (lane >> 3) + 8 * j; const LAS float* s = scr + (8 * c) * 33 + n;
        v4u o; o.x = pk2(s[0 * 33], s[1 * 33]); o.y = pk2(s[2 * 33], s[3 * 33]); o.z = pk2(s[4 * 33], s[5 * 33]); o.w = pk2(s[6 * 33], s[7 * 33]);
        *(GAS v4u*)(d.WT + (size_t)(d.drow0 + n) * d.ldk + d.koff + d.k0 + 8 * c) = o; }
    LDS_WAIT(); asm volatile("" ::: "memory");
}
__device__ __forceinline__ void p0_transpose_item(const float* W, int N, bf16* WT, int ldk, int koff, int k0, int scol0, int drow0, const float* ks, LAS float* scr, int lane) {
    const P0Item d{W, N, WT, ldk, koff, k0, scol0, drow0, ks, 1.0f}; float wv[32]; p0_item_load(d, wv, lane); p0_item_finish(d, wv, scr, lane);
}
__device__ __forceinline__ void p0_plain(const float* W, int K, int N, bf16* WT, int ldk, int koff, int item, LAS float* scr, int lane) {
    const int nblk = N / 32, kb = item / nblk, nb = item % nblk;
    p0_transpose_item(W, N, WT, ldk, koff, 64 * kb, 32 * nb, 32 * nb, nullptr, scr, lane);
}
__device__ __forceinline__ void rms_rows4_to_bf16(const float* x, const float* gain, bf16* o, int m0, int rstride, int lane) {
    f32x4 v[4][4]; float s[4];
#pragma unroll
    for (int r = 0; r < 4; ++r) { const GAS f32x4* xr = (const GAS f32x4*)(x + (size_t)(m0 + r * rstride) * D) + lane;
#pragma unroll
        for (int j = 0; j < 4; ++j) v[r][j] = xr[64 * j]; }
    f32x4 g[4];
#pragma unroll
    for (int j = 0; j < 4; ++j) g[j] = ((const GAS f32x4*)gain + lane)[64 * j];
#pragma unroll
    for (int r = 0; r < 4; ++r) { float t = 0.f;
#pragma unroll
        for (int j = 0; j < 4; ++j) t += (v[r][j].x * v[r][j].x + v[r][j].y * v[r][j].y) + (v[r][j].z * v[r][j].z + v[r][j].w * v[r][j].w);
        s[r] = 1.0f / sqrtf(wave_sum(t) * (1.f / 1024.f) + RMS_EPS); }
#pragma unroll
    for (int r = 0; r < 4; ++r) { GAS unsigned long long* o8 = (GAS unsigned long long*)(o + (size_t)(m0 + r * rstride) * D) + lane;
#pragma unroll
        for (int j = 0; j < 4; ++j) o8[64 * j] = (unsigned long long)pk2(v[r][j].x * s[r] * g[j].x, v[r][j].y * s[r] * g[j].y) | ((unsigned long long)pk2(v[r][j].z * s[r] * g[j].z, v[r][j].w * s[r] * g[j].w) << 32); }
}
template <int NR> __device__ __forceinline__ void rmsN_load(const float* x, int m0, f32x4 (&v)[NR][4], int lane) {
#pragma unroll
    for (int r = 0; r < NR; ++r) { const GAS f32x4* xr = (const GAS f32x4*)(x + (size_t)(m0 + r) * D) + lane;
#pragma unroll
        for (int j = 0; j < 4; ++j) v[r][j] = xr[64 * j]; }
}
template <int NR> __device__ __forceinline__ void rmsN_finish(const f32x4 (&v)[NR][4], const f32x4 (&g)[4], bf16* o, int m0, int lane) {
    float s[NR];
#pragma unroll
    for (int r = 0; r < NR; ++r) { float t = 0.f;
#pragma unroll
        for (int j = 0; j < 4; ++j) t += (v[r][j].x * v[r][j].x + v[r][j].y * v[r][j].y) + (v[r][j].z * v[r][j].z + v[r][j].w * v[r][j].w);
        s[r] = 1.0f / sqrtf(wave_sum(t) * (1.f / 1024.f) + RMS_EPS); }
#pragma unroll
    for (int r = 0; r < NR; ++r) { GAS unsigned long long* o8 = (GAS unsigned long long*)(o + (size_t)(m0 + r) * D) + lane;
#pragma unroll
        for (int j = 0; j < 4; ++j) o8[64 * j] = (unsigned long long)pk2(v[r][j].x * s[r] * g[j].x, v[r][j].y * s[r] * g[j].y) | ((unsigned long long)pk2(v[r][j].z * s[r] * g[j].z, v[r][j].w * s[r] * g[j].w) << 32); }
}
__device__ __forceinline__ void p0_prologue(Frame& F, const Args& A) {
    LAS float* scr = (LAS float*)(F.lds + RING_OFF + F.wave * 16384);
    const int gw = F.vcu * NWAVES + F.wave, NGW = F.G * NWAVES;
    bf16* WIN = (bf16*)(A.ws + WS_WIN); bf16* WFI = (bf16*)(A.ws + WS_WFI); bf16* WFO = (bf16*)(A.ws + WS_WFO); bf16* WPC = (bf16*)(A.ws + WS_WPC); bf16* WO = (bf16*)(A.ws + WS_WO); bf16* WKV = (bf16*)(A.ws + WS_WKV);
    constexpr int I_IN = 16 * (INC / 32), I_FI = 16 * (2 * DFF / 32), I_FO = (DFF / 64) * 32, I_PH = 16 * 32, I_PD = 8 * 32, I_PM = 8 * 32, I_O = 16 * 32, I_KV = 16 * 32;
    constexpr int NITEMS = I_IN + I_FI + I_FO + I_PH + I_PD + I_PM + I_O + I_KV;
    auto desc = [&](int it, P0Item& d) -> bool {
        int r = it;
        if (DEFER_T) { if (r >= I_IN) r += I_FI + I_FO; if (r >= I_IN + I_FI + I_FO + I_PH + I_PD + I_PM) r += I_O; }
        auto plain = [&](const float* W, int K, int N, bf16* WT, int ldk, int koff, int item) { const int nblk = N / 32, kb = item / nblk, nb = item % nblk; (void)K; d = P0Item{W, N, WT, ldk, koff, 64 * kb, 32 * nb, 32 * nb, nullptr, 1.0f}; };
        if (r < I_IN) { plain(A.in[4], 1024, INC, WIN, 1024, 0, r);
            const int n0 = d.scol0; if (n0 < 3072 || (n0 >= 4096 && n0 < 5120) || n0 >= 10240) d.cs = -1.4426950408889634f; return true; } r -= I_IN;
        if (r < I_FI) { if (DEFER_T) return false;
            const int nblk = 2 * DFF / 32, kb = r / nblk, nb = r % nblk, d0 = 32 * nb, tile = d0 >> 8, within = d0 & 255;
            const int sc = within < 128 ? 128 * tile + within : DFF + 128 * tile + (within - 128);
            d = P0Item{A.in[18], 2 * DFF, WFI, 1024, 0, 64 * kb, sc, d0, A.in[17], 1.0f}; return true; } r -= I_FI;
        if (r < I_FO) { if (DEFER_T) return false; plain(A.in[19], DFF, 1024, WFO, DFF, 0, r); return true; } r -= I_FO;
        if (r < I_PH) { plain(A.in[13], 1024, 1024, WPC, 2048, 0, r); return true; } r -= I_PH;
        if (r < I_PD) { plain(A.in[14], 512, 1024, WPC, 2048, 1024, r); return true; } r -= I_PD;
        if (r < I_PM) { plain(A.in[15], 512, 1024, WPC, 2048, 1536, r); return true; } r -= I_PM;
        if (r < I_O) { if (DEFER_T) return false; plain(A.in[16], 1024, 1024, WO, 1024, 0, r); return true; } r -= I_O;
        plain(A.in[10], 1024, 1024, WKV, 1024, 0, r); return true; };
    bf16* H = (bf16*)(A.ws + WS_H); bf16* MEMN = (bf16*)(A.ws + WS_MEMN);
    constexpr int NR = DEFER_R ? 3 : 4; const int Q = (DEFER_R ? GR + 2048 : MTOK) / NR;
    static_assert((GR + 2048) % 3 == 0 && MTOK % 4 == 0, "row steps");
    f32x4 vm[1][4], vA[NR][4], vB[NR][4]; int q = gw, qA = 0, qB = 0;
    if (gw < BATCH * NMEM) rmsN_load<1>(A.in[1], gw, vm, F.lane);
    const bool hrow0 = q < Q; if (hrow0) { qA = q; q += NGW; rmsN_load<NR>(A.in[0], NR * qA, vA, F.lane); }
    { int it = gw; P0Item dA, dB; float wA[32], wB[32]; bool hA = false, hB = false;
#define P0_NEXT(H_, D_, W_) do { H_ = false; while (it < (DEFER_T ? NITEMS - I_FI - I_FO - I_O : NITEMS)) { const bool ok_ = desc(it, D_); it += NGW; if (ok_) { H_ = true; break; } } if (H_) p0_item_load(D_, W_, F.lane); } while (0)
        P0_NEXT(hA, dA, wA);
        while (hA) {
            P0_NEXT(hB, dB, wB);
            p0_item_finish(dA, wA, scr, F.lane);
            if (!hB) break;
            P0_NEXT(hA, dA, wA);
            p0_item_finish(dB, wB, scr, F.lane);
        }
#undef P0_NEXT
    }
    { f32x4 g4[4];
#pragma unroll
        for (int j = 0; j < 4; ++j) g4[j] = ((const GAS f32x4*)A.in[2] + F.lane)[64 * j];
        if (hrow0) {
            for (;;) { const bool hB = q < Q; if (hB) { qB = q; q += NGW; rmsN_load<NR>(A.in[0], NR * qB, vB, F.lane); }
                rmsN_finish<NR>(vA, g4, H, NR * qA, F.lane); if (!hB) break;
                const bool hA = q < Q; if (hA) { qA = q; q += NGW; rmsN_load<NR>(A.in[0], NR * qA, vA, F.lane); }
                rmsN_finish<NR>(vB, g4, H, NR * qB, F.lane); if (!hA) break; } }
#pragma unroll
        for (int j = 0; j < 4; ++j) g4[j] = ((const GAS f32x4*)A.in[3] + F.lane)[64 * j];
        if (gw < BATCH * NMEM) rmsN_finish<1>(vm, g4, MEMN, gw, F.lane);
        for (int m = gw + NGW; m < BATCH * NMEM; m += NGW) { rmsN_load<1>(A.in[1], m, vm, F.lane); rmsN_finish<1>(vm, g4, MEMN, m, F.lane); } }
    float* LB = (float*)(A.ws + WS_LB);
    for (int i = gw * 64 + F.lane; i < 2048; i += NGW * 64) { const float* lg = (i < 1024) ? A.in[5] : A.in[6]; const int c = i & 1023; LB[i] = 1.0f / (1.0f + __expf(lg[1024 + c] - lg[c])); }
}


constexpr int DF_IO = 16 * 32, DF_IFI = 16 * (2 * DFF / 32), DF_IFO = (DFF / 64) * 32, DF_NT = DF_IO + DF_IFI + DF_IFO;
__device__ __forceinline__ void p0_deferred_item(const Args& A, int t, LAS float* scr, int lane) {
    bf16* WFI = (bf16*)(A.ws + WS_WFI); bf16* WFO = (bf16*)(A.ws + WS_WFO); bf16* WO = (bf16*)(A.ws + WS_WO);
    if (t < DF_IO) { p0_plain(A.in[16], 1024, 1024, WO, 1024, 0, t, scr, lane); return; } t -= DF_IO;
    if (t < DF_IFI) { const int nblk = 2 * DFF / 32, kb = t / nblk, nb = t % nblk, d0 = 32 * nb, tile = d0 >> 8, within = d0 & 255;
        const int sc = within < 128 ? 128 * tile + within : DFF + 128 * tile + (within - 128);
        p0_transpose_item(A.in[18], 2 * DFF, WFI, 1024, 0, 64 * kb, sc, d0, A.in[17], scr, lane); return; } t -= DF_IFI;
    p0_plain(A.in[19], DFF, 1024, WFO, DFF, 0, t, scr, lane);
}
struct DeferFill { int seam, wave, lane, vcu, G; LAS unsigned char* lds;
    __device__ __forceinline__ void operator()() const {
        if (MK_PER_PHASE) return;
#if defined(__HIP_DEVICE_COMPILE__)
        Args A; { const __attribute__((address_space(4))) Args* ap_ = (const __attribute__((address_space(4))) Args*)__builtin_amdgcn_kernarg_segment_ptr(); asm volatile("" : "+s"(ap_)); A = *ap_; }
        const int wi = vcu * 7 + (wave - 1), NW = G * 7;
        if (seam == 1 || seam == 2) { if (!DEFER_R) return;
            bf16* H = (bf16*)(A.ws + WS_H); const int per = (4096 - 512 + 1) / 2;
            for (int q = 512 + (seam - 1) * per + wi; q < 512 + seam * per && q < 4096; q += NW) rms_rows4_to_bf16(A.in[0], A.in[2], H, GR + 4 * q, 1, lane);
        } else { const int part = seam == 3 ? 0 : seam - 4;
            if (part < 0 || part > 5) return;
            LAS float* scr = (LAS float*)(lds + RING_OFF + wave * 16384);
            const int lo = part * (DF_NT / 6), hi = part == 5 ? DF_NT : (part + 1) * (DF_NT / 6);
            if (DEFER_T) for (int t = lo + wi; t < hi; t += NW) p0_deferred_item(A, t, scr, lane);
            if ((seam == 3 || seam == 7) && wave <= 6) {
                pg8::StaticOrder S; S.init(GR, 1024, G, (int)blockIdx.x); pg8::Unit u;
                if (S.next(0, u)) { const unsigned char* gp = (const unsigned char*)A.out + OUT_GATES + (size_t)(seam == 7 ? 1 : 0) * (48u << 20) + ((size_t)(((wave - 1) >> 1) * 64 + u.pm) * 4 + u.pn) * 65536 + ((wave - 1) & 1) * 32768 + lane * 16;
                    unsigned acc = 0u;
#pragma unroll 8
                    for (int i = 0; i < 32; ++i) { const v4u v = *(const v4u*)(gp + i * 1024); acc += (v.x ^ v.y) + (v.z ^ v.w); }
                    if (acc == 0x9e3779b9u) ((unsigned*)(A.ws + WS_CTL))[2048 + lane] = acc; } } }
#endif
    } };

struct RotOrder : pg8::StaticOrder {
    __device__ __forceinline__ bool next(int i, pg8::Unit& u) const { const bool ok = pg8::StaticOrder::next(i, u); if (ok) { u.pn += 40; if (u.pn >= 52) u.pn -= 52; } return ok; }
};
struct RevOrder : pg8::StaticOrder {
    __device__ __forceinline__ bool next(int i, pg8::Unit& u) const { const int n = (nwg - c + G - 1) / G; if (i >= n) return false; return pg8::StaticOrder::next(n - 1 - i, u); }
};
namespace att {
using bf16x8 = __attribute__((ext_vector_type(8))) short;
using s16x4  = __attribute__((ext_vector_type(4))) short;
using f32x16 = __attribute__((ext_vector_type(16))) float;
using u32x4  = __attribute__((ext_vector_type(4))) unsigned;
#define KSWZ(row, colB) ((row) * 256 + ((colB) ^ (((row) & 7) << 4)))
#define SBAR() __builtin_amdgcn_sched_barrier(0)
__device__ __forceinline__ int crow(int r, int hi) { return (r & 3) + 8 * (r >> 2) + 4 * hi; }
__device__ __forceinline__ unsigned cvtpk(float lo, float hi) { unsigned r; asm volatile("v_cvt_pk_bf16_f32 %0, %1, %2" : "=v"(r) : "v"(lo), "v"(hi)); return r; }
constexpr int SHM_K = 64 * 128 * 2, SHM_V = 64 * 128 * 2;
constexpr int OFF_V = 0, OFF_K = 2 * SHM_V, OFF_WS = 2 * SHM_V + 2 * SHM_K;
__device__ __forceinline__ void qkt(f32x16& p0, f32x16& p1, const char* Ks, const bf16x8* qr, int r32, int hi) {
  p0 = f32x16{}; p1 = f32x16{};
#pragma unroll
  for (int d0 = 0; d0 < 8; ++d0) { const int cb = (d0 * 16 + hi * 8) * 2;
    const bf16x8 b0 = *reinterpret_cast<const bf16x8*>(Ks + KSWZ(r32, cb));
    const bf16x8 b1 = *reinterpret_cast<const bf16x8*>(Ks + KSWZ(32 + r32, cb));
    p0 = __builtin_amdgcn_mfma_f32_32x32x16_bf16(b0, qr[d0], p0, 0, 0, 0);
    p1 = __builtin_amdgcn_mfma_f32_32x32x16_bf16(b1, qr[d0], p1, 0, 0, 0); }
}
__device__ __forceinline__ void qkt_half(f32x16& p, const char* Ks, const bf16x8* qr, int krow, int hi) {
  p = f32x16{};
#pragma unroll
  for (int d0 = 0; d0 < 8; ++d0) { const int cb = (d0 * 16 + hi * 8) * 2;
    const bf16x8 b = *reinterpret_cast<const bf16x8*>(Ks + KSWZ(krow, cb));
    p = __builtin_amdgcn_mfma_f32_32x32x16_bf16(b, qr[d0], p, 0, 0, 0); }
}
__device__ __forceinline__ int v_st(int k, int c) { const int kk = (k & ~0xC) | ((k & 4) << 1) | ((k & 8) >> 1); return ((kk >> 3) * 4 + (c >> 5)) * 512 + ((kk & 7) * 32 + (c & 31)) * 2; }
__device__ __forceinline__ int v_rd_base(int lane) { return ((lane & 3) << 3) | (((lane >> 2) & 3) << 6) | (((lane >> 4) & 1) << 5) | (((lane >> 5) & 1) << 8); }
constexpr int v_rd_off(int d0, int ks, int half) { return d0 * 512 + ks * 4096 + half * 2048; }
template <int OFF> __device__ __forceinline__ s16x4 tr_read(int vb) { s16x4 r; asm volatile("ds_read_b64_tr_b16 %0, %1 offset:%2" : "=&v"(r) : "v"(vb), "i"(OFF) : "memory"); return r; }
template <int D0> __device__ __forceinline__ void pv_one(f32x16& od, int vb, bf16x8 pa0, bf16x8 pa1, bf16x8 pa2, bf16x8 pa3) {
  const s16x4 l0 = tr_read<v_rd_off(D0, 0, 0)>(vb), h0 = tr_read<v_rd_off(D0, 0, 1)>(vb), l1 = tr_read<v_rd_off(D0, 1, 0)>(vb), h1 = tr_read<v_rd_off(D0, 1, 1)>(vb);
  const s16x4 l2 = tr_read<v_rd_off(D0, 2, 0)>(vb), h2 = tr_read<v_rd_off(D0, 2, 1)>(vb), l3 = tr_read<v_rd_off(D0, 3, 0)>(vb), h3 = tr_read<v_rd_off(D0, 3, 1)>(vb);
  asm volatile("s_waitcnt lgkmcnt(0)" ::: "memory"); SBAR();
#define PK(L, H) (bf16x8){L[0], L[1], L[2], L[3], H[0], H[1], H[2], H[3]}
  od = __builtin_amdgcn_mfma_f32_32x32x16_bf16(pa0, PK(l0, h0), od, 0, 0, 0);
  od = __builtin_amdgcn_mfma_f32_32x32x16_bf16(pa1, PK(l1, h1), od, 0, 0, 0);
  od = __builtin_amdgcn_mfma_f32_32x32x16_bf16(pa2, PK(l2, h2), od, 0, 0, 0);
  od = __builtin_amdgcn_mfma_f32_32x32x16_bf16(pa3, PK(l3, h3), od, 0, 0, 0);
#undef PK
}
template <int D0, int H> __device__ __forceinline__ void pv_half(f32x16& od, int vb, bf16x8 paA, bf16x8 paB) {
  const s16x4 l0 = tr_read<v_rd_off(D0, 2 * H, 0)>(vb), h0 = tr_read<v_rd_off(D0, 2 * H, 1)>(vb), l1 = tr_read<v_rd_off(D0, 2 * H + 1, 0)>(vb), h1 = tr_read<v_rd_off(D0, 2 * H + 1, 1)>(vb);
  asm volatile("s_waitcnt lgkmcnt(0)" ::: "memory"); SBAR();
#define PK(L, H_) (bf16x8){L[0], L[1], L[2], L[3], H_[0], H_[1], H_[2], H_[3]}
  od = __builtin_amdgcn_mfma_f32_32x32x16_bf16(paA, PK(l0, h0), od, 0, 0, 0);
  od = __builtin_amdgcn_mfma_f32_32x32x16_bf16(paB, PK(l1, h1), od, 0, 0, 0);
#undef PK
}
__device__ __forceinline__ void attn_unit(const bf16* Qb, long QS, const bf16* Kb, const bf16* Vb, long KS, int ntile, int tile0, int Ld, int n0, bool band, float slope2,
                                          bf16* Ob, long OS, float* lsep, long LS, LAS unsigned char* ldsb, int tid_in, unsigned long long* PRB) {
  int tid = tid_in; asm volatile("" : "+v"(tid));
  const int wid = __builtin_amdgcn_readfirstlane(tid >> 6), lane = tid & 63, r32 = lane & 31, hi = lane >> 5;
#define AT_T(var) unsigned long long var = 0; if (HG_PROBE) var = __builtin_amdgcn_s_memrealtime()
#define AT_ACC(slot, a_, b_) do { if (HG_PROBE && blockIdx.x == 0 && wid == 0 && lane == 0) PRB[slot] += (b_) - (a_); } while (0)
  AT_T(ta0);
  char* lds = (char*)ldsb;
  char* V_lds = lds + OFF_V; char* K_lds = lds + OFF_K;
  float* wsf = (float*)(lds + OFF_WS) + wid * 64; float* li_l = wsf; float* al_l = wsf + 32;
  float m_reg = -1e30f, l_reg = 0.f; f32x16 o[4] = {}; bf16x8 qr[8];
  const bf16* Qw = Qb + (long)(wid * 32 + r32) * QS + hi * 8;
#pragma unroll
  for (int d0 = 0; d0 < 8; ++d0) qr[d0] = *reinterpret_cast<const bf16x8*>(Qw + d0 * 16);
  const int sr = tid >> 4, sc = (tid & 15) * 8, vst0 = v_st(sr, sc), vst1 = v_st(32 + sr, sc);
  const int vb0 = (int)(uintptr_t)V_lds + v_rd_base(lane);
  int t_lo = 0, t_hi = ntile;
  while (t_lo < t_hi && (tile0 + 64 * t_lo) < 0) ++t_lo;
  while (t_hi > t_lo && (tile0 + 64 * (t_hi - 1)) >= Ld) --t_hi;
  bf16x8 vs0, vs1, ks0, ks1;
#define SLOAD(tau) do { const long k0_ = (long)(tile0 + 64 * (tau)); vs0 = *reinterpret_cast<const bf16x8*>(Vb + (k0_ + sr) * KS + sc); vs1 = *reinterpret_cast<const bf16x8*>(Vb + (k0_ + 32 + sr) * KS + sc); \
    ks0 = *reinterpret_cast<const bf16x8*>(Kb + (k0_ + sr) * KS + sc); ks1 = *reinterpret_cast<const bf16x8*>(Kb + (k0_ + 32 + sr) * KS + sc); } while (0)
#define SWRITE(b) do { *(bf16x8*)(V_lds + (b) * SHM_V + vst0) = vs0; *(bf16x8*)(V_lds + (b) * SHM_V + vst1) = vs1; const int kc_ = sc * 2; \
    *(bf16x8*)(K_lds + (b) * SHM_K + KSWZ(sr, kc_)) = ks0; *(bf16x8*)(K_lds + (b) * SHM_K + KSWZ(32 + sr, kc_)) = ks1; } while (0)
  SLOAD(t_lo); SWRITE(0); __syncthreads();
  AT_T(ta1); AT_ACC(8, ta0, ta1);
  const int w_lo = wid >> 1;
  for (int tau = t_lo; tau < t_hi; ++tau) {
    const int buf = (tau - t_lo) & 1;
    if (tau + 1 < t_hi) SLOAD(tau + 1);
    const bool active = !band || (tau >= w_lo && tau <= w_lo + 2);
    if (active) {
      const bool h0 = !(band && tau == w_lo && (wid & 1)), h1 = !(band && tau == w_lo + 2 && !(wid & 1));
      f32x16 p0 = f32x16{}, p1 = f32x16{};
      if (h0) qkt_half(p0, K_lds + buf * SHM_K, qr, r32, hi);
      if (h1) qkt_half(p1, K_lds + buf * SHM_K, qr, 32 + r32, hi);
      if (band) { const int rel0 = (tile0 + 64 * tau) - (n0 + wid * 32 + r32);
        if (h0) {
#pragma unroll
          for (int r = 0; r < 16; ++r) { const int ra = rel0 + crow(r, hi); const int aa = ra < 0 ? -ra : ra; p0[r] = aa <= 64 ? p0[r] - slope2 * (float)aa : -2e30f; } }
        if (h1) {
#pragma unroll
          for (int r = 0; r < 16; ++r) { const int rb = rel0 + crow(r, hi) + 32; const int ab = rb < 0 ? -rb : rb; p1[r] = ab <= 64 ? p1[r] - slope2 * (float)ab : -2e30f; } } }
      float pmax = -3e38f;
      if (h0) {
#pragma unroll
        for (int r = 0; r < 16; ++r) pmax = fmaxf(pmax, p0[r]); }
      if (h1) {
#pragma unroll
        for (int r = 0; r < 16; ++r) pmax = fmaxf(pmax, p1[r]); }
      { auto rr = __builtin_amdgcn_permlane32_swap(__float_as_uint(pmax), __float_as_uint(pmax), false, false); pmax = fmaxf(__uint_as_float(rr[0]), __uint_as_float(rr[1])); }
      const float mn = fmaxf(m_reg, pmax), alpha = __builtin_amdgcn_exp2f(m_reg - mn); m_reg = mn;
      float ps = 0.f;
      if (h0) { p0 = p0 - mn;
#pragma unroll
        for (int r = 0; r < 16; ++r) p0[r] = __builtin_amdgcn_exp2f(p0[r]);
        ps += ((p0[0] + p0[1]) + (p0[2] + p0[3])) + ((p0[4] + p0[5]) + (p0[6] + p0[7])) + (((p0[8] + p0[9]) + (p0[10] + p0[11])) + ((p0[12] + p0[13]) + (p0[14] + p0[15]))); }
      if (h1) { p1 = p1 - mn;
#pragma unroll
        for (int r = 0; r < 16; ++r) p1[r] = __builtin_amdgcn_exp2f(p1[r]);
        ps += ((p1[0] + p1[1]) + (p1[2] + p1[3])) + ((p1[4] + p1[5]) + (p1[6] + p1[7])) + (((p1[8] + p1[9]) + (p1[10] + p1[11])) + ((p1[12] + p1[13]) + (p1[14] + p1[15]))); }
      { auto rr = __builtin_amdgcn_permlane32_swap(__float_as_uint(ps), __float_as_uint(ps), false, false); ps = __uint_as_float(rr[0]) + __uint_as_float(rr[1]); }
      l_reg = l_reg * alpha + ps;
      if (__any(alpha < 1.f)) { if (hi == 0) al_l[r32] = alpha; asm volatile("s_waitcnt lgkmcnt(0)" ::: "memory");
#pragma unroll
        for (int d = 0; d < 4; ++d)
#pragma unroll
          for (int r = 0; r < 16; ++r) o[d][r] *= al_l[crow(r, hi)]; }
#define PK4(P, BASE, OUT) do { unsigned a0 = cvtpk(P[BASE + 0], P[BASE + 1]), a1 = cvtpk(P[BASE + 2], P[BASE + 3]);   \
    unsigned b0 = cvtpk(P[BASE + 4], P[BASE + 5]), b1 = cvtpk(P[BASE + 6], P[BASE + 7]);                              \
    auto r0 = __builtin_amdgcn_permlane32_swap(a0, b0, false, false); auto r1 = __builtin_amdgcn_permlane32_swap(a1, b1, false, false); \
    u32x4 w = {r0[0], r1[0], r0[1], r1[1]}; OUT = *reinterpret_cast<bf16x8*>(&w); } while (0)
      const int vb = vb0 + buf * SHM_V;
      if (h0) { bf16x8 pa0, pa1; PK4(p0, 0, pa0); PK4(p0, 8, pa1);
        pv_half<0, 0>(o[0], vb, pa0, pa1); pv_half<1, 0>(o[1], vb, pa0, pa1); pv_half<2, 0>(o[2], vb, pa0, pa1); pv_half<3, 0>(o[3], vb, pa0, pa1); }
      if (h1) { bf16x8 pa2, pa3; PK4(p1, 0, pa2); PK4(p1, 8, pa3);
        pv_half<0, 1>(o[0], vb, pa2, pa3); pv_half<1, 1>(o[1], vb, pa2, pa3); pv_half<2, 1>(o[2], vb, pa2, pa3); pv_half<3, 1>(o[3], vb, pa2, pa3); }
#undef PK4
    }
    if (tau + 1 < t_hi) SWRITE(buf ^ 1);
    __syncthreads();
  }
  AT_T(ta2); AT_ACC(9, ta1, ta2);
  if (hi == 0) li_l[r32] = l_reg; asm volatile("s_waitcnt lgkmcnt(0)" ::: "memory");
  if (lsep && hi == 0) lsep[(long)(wid * 32 + r32) * LS] = m_reg + __log2f(l_reg);
  float rli[16];
#pragma unroll
  for (int r = 0; r < 16; ++r) rli[r] = __builtin_amdgcn_rcpf(li_l[crow(r, hi)]);
  bf16* Ow = Ob + (long)(wid * 32) * OS;
#pragma unroll
  for (int r = 0; r < 16; ++r) { const int orow = crow(r, hi);
#pragma unroll
    for (int d0 = 0; d0 < 4; ++d0) Ow[(long)orow * OS + d0 * 32 + r32] = (bf16)f2bf(o[d0][r] * rli[r]); }
  __syncthreads();
  AT_T(ta3); AT_ACC(10, ta2, ta3);
#undef SLOAD
#undef SWRITE
}
#undef KSWZ
#undef SBAR
}


namespace hg {
using bf16x8 = __attribute__((ext_vector_type(8))) short;
using f32x16 = __attribute__((ext_vector_type(16))) float;
using u32x4  = __attribute__((ext_vector_type(4))) unsigned;
using u32x2  = __attribute__((ext_vector_type(2))) unsigned;
typedef short v4i16_t __attribute__((ext_vector_type(4)));
constexpr int L_QIN = 0, L_KIN = 16384, L_V = 16384 + 18432, L_DEC = L_V + 20480, L_DIRBYTES = 65536;
constexpr int L_SSQ = L_DEC + 512;
constexpr int L_CNT = 2 * L_DIRBYTES - 64;
static_assert(L_SSQ + 1024 <= L_DIRBYTES - 64, "hgrn LDS map");
__device__ __forceinline__ int crow(int r, int hi) { return (r & 3) + 8 * (r >> 2) + 4 * hi; }
typedef float f32x2_t __attribute__((ext_vector_type(2))); typedef __bf16 bf16x2_t __attribute__((ext_vector_type(2)));
__device__ __forceinline__ unsigned cvtpk(float lo, float hi) { const f32x2_t v = {lo, hi}; const bf16x2_t b = __builtin_convertvector(v, bf16x2_t); return __builtin_bit_cast(unsigned, b); }
__device__ __forceinline__ bf16x8 trfrag(const LAS unsigned char* lo, const LAS unsigned char* hi) {
  const v4i16_t a = __builtin_amdgcn_ds_read_tr16_b64_v4i16((LAS v4i16_t*)lo), b = __builtin_amdgcn_ds_read_tr16_b64_v4i16((LAS v4i16_t*)hi);
  return (bf16x8){a[0], a[1], a[2], a[3], b[0], b[1], b[2], b[3]};
}
__device__ __forceinline__ bf16x8 accfrag(const f32x16& x, int s2) {
  u32x4 w; const int b = 8 * s2; w.x = cvtpk(x[b + 0], x[b + 1]); w.y = cvtpk(x[b + 2], x[b + 3]); w.z = cvtpk(x[b + 4], x[b + 5]); w.w = cvtpk(x[b + 6], x[b + 7]); return __builtin_bit_cast(bf16x8, w);
}
__device__ __forceinline__ void swz_pack(const u32x2 (&w)[4], u32x4& c0, u32x4& c1) {
  const auto rx02 = __builtin_amdgcn_permlane32_swap(w[0].x, w[2].x, false, false), ry02 = __builtin_amdgcn_permlane32_swap(w[0].y, w[2].y, false, false);
  const auto rx13 = __builtin_amdgcn_permlane32_swap(w[1].x, w[3].x, false, false), ry13 = __builtin_amdgcn_permlane32_swap(w[1].y, w[3].y, false, false);
  c0 = (u32x4){rx02[0], ry02[0], rx02[1], ry02[1]}; c1 = (u32x4){rx13[0], ry13[0], rx13[1], ry13[1]};
}
__device__ __forceinline__ void swz_unpack(const u32x4& c0, const u32x4& c1, u32x2 (&w)[4]) {
  const auto rx02 = __builtin_amdgcn_permlane32_swap(c0.x, c0.z, false, false), ry02 = __builtin_amdgcn_permlane32_swap(c0.y, c0.w, false, false);
  const auto rx13 = __builtin_amdgcn_permlane32_swap(c1.x, c1.z, false, false), ry13 = __builtin_amdgcn_permlane32_swap(c1.y, c1.w, false, false);
  w[0] = (u32x2){rx02[0], ry02[0]}; w[2] = (u32x2){rx02[1], ry02[1]}; w[1] = (u32x2){rx13[0], ry13[0]}; w[3] = (u32x2){rx13[1], ry13[1]};
}
__device__ __forceinline__ void dir_bar(LAS unsigned* cnt, unsigned& target, int lane) {
  asm volatile("s_waitcnt lgkmcnt(0)" ::: "memory");
  if (lane == 0) __hip_atomic_fetch_add(cnt, 1u, __ATOMIC_RELAXED, __HIP_MEMORY_SCOPE_WORKGROUP);
  target += 4u;
  while ((int)(__hip_atomic_load(cnt, __ATOMIC_RELAXED, __HIP_MEMORY_SCOPE_WORKGROUP) - target) < 0) __builtin_amdgcn_s_sleep(0);
  asm volatile("" ::: "memory");
}
#ifndef HG_PROBE
#define HG_PROBE 0
#endif
#define HG_T(var) unsigned long long var = 0; if (HG_PROBE) var = __builtin_amdgcn_s_memrealtime()
#define HG_ACC(slot, t0_, t1_) do { if (HG_PROBE && FULL && blockIdx.x == 0 && wave == 0 && lane == 0) PRB[slot] += (t1_) - (t0_); } while (0)
template <bool FULL>
__device__ __forceinline__ void hgrn_item(const bf16* Q, const bf16* V, bf16* LFf, bf16* LFb, const bf16* GG, const float* GAIN, bf16* OC, float* SL, float* DT, int sbh, int sj, LAS unsigned char* ldsb, int tid, unsigned long long* PRB) {
  const int wave = __builtin_amdgcn_readfirstlane(tid >> 6), lane = tid & 63, dir = wave >> 2, dw = wave & 3;
  LAS unsigned char* L = ldsb + dir * L_DIRBYTES;
  bf16* LF = dir ? LFb : LFf; const int stream = sbh * 2 + dir;
  LAS unsigned* cnt = (LAS unsigned*)(ldsb + L_CNT) + dir;
  if (tid < 2) ((LAS unsigned*)(ldsb + L_CNT))[tid] = 0u;
  __syncthreads();
  unsigned target = 0u;
#define LANE_E() int ln_ = lane; asm volatile("" : "+v"(ln_)); const int ig = ln_ >> 4, tq = ln_ & 15, i0 = 32 * dw + 8 * ig
#define LANE_M() int ln_ = lane; asm volatile("" : "+v"(ln_)); const int h = ln_ >> 5, r32 = ln_ & 31, jrow = (ln_ & 15) >> 2, c4 = 16 * ((ln_ >> 4) & 1) + 4 * (ln_ & 3); \
  const int qbase0 = (4 * h + jrow) * 128 + ((((jrow >> 1) & 1)) << 6) + c4 * 2, kbase = (4 * h + jrow) * 144 + c4 * 2, vpbase = (4 * h + jrow) * 320 + (32 * dw + c4) * 2, \
            vnbase = (8 * h + jrow) * 320 + (32 * dw + c4) * 2, knbase = r32 * 144 + 16 * h
  f32x16 S[4];
#pragma unroll
  for (int ib = 0; ib < 4; ++ib) S[ib] = f32x16{};
  HG_T(tp0);
  if (FULL) { LANE_M();
    const int nprev = dir ? 7 - sj : sj;
    for (int idx = 64 * dw + lane; idx < nprev * 128; idx += 256) { const int p = idx >> 7, sp = dir ? 7 - p : p; ((LAS float*)(L + L_QIN))[idx] = DT[((size_t)stream * 8 + sp) * 128 + (idx & 127)]; }
    dir_bar(cnt, target, lane);
    u32x4 a0[8], a1[8];
#define HG_PLOAD(A_, P_) do { const int sp_ = dir ? 7 - (P_) : (P_); const bf16* sl_ = (const bf16*)SL + ((((size_t)stream * 8 + sp_) * 4 + dw) * 4) * 1024 + lane * 16; \
      _Pragma("unroll") for (int ib = 0; ib < 4; ++ib) { A_[2 * ib] = *(const u32x4*)(sl_ + ib * 1024); A_[2 * ib + 1] = *(const u32x4*)(sl_ + ib * 1024 + 8); } } while (0)
#define HG_PFMA(A_, P_) do { _Pragma("unroll") for (int ib = 0; ib < 4; ++ib) _Pragma("unroll") for (int g4 = 0; g4 < 4; ++g4) { const f32x4 d_ = *(const LAS f32x4*)(L + L_QIN + ((P_) * 128 + 32 * ib + 8 * g4 + 4 * h) * 4); \
      const u32x4 w_ = A_[2 * ib + (g4 >> 1)]; const unsigned wl_ = (g4 & 1) ? w_.z : w_.x, wh_ = (g4 & 1) ? w_.w : w_.y; \
      S[ib][4 * g4] = S[ib][4 * g4] * d_[0] + blo(wl_); S[ib][4 * g4 + 1] = S[ib][4 * g4 + 1] * d_[1] + bhi(wl_); S[ib][4 * g4 + 2] = S[ib][4 * g4 + 2] * d_[2] + blo(wh_); S[ib][4 * g4 + 3] = S[ib][4 * g4 + 3] * d_[3] + bhi(wh_); } } while (0)
    if (nprev > 0) HG_PLOAD(a0, 0);
    for (int p = 0; p < nprev; p += 2) {
      if (p + 1 < nprev) HG_PLOAD(a1, p + 1);
      HG_PFMA(a0, p);
      if (p + 1 < nprev) { if (p + 2 < nprev) HG_PLOAD(a0, p + 2); HG_PFMA(a1, p + 1); }
    }
#undef HG_PLOAD
#undef HG_PFMA
    dir_bar(cnt, target, lane);
  }
  HG_T(tp1); HG_ACC(5, tp0, tp1);
  float sumbl[8];
#pragma unroll
  for (int e = 0; e < 8; ++e) sumbl[e] = 0.f;
  u32x4 v8[4], q8[4], f8[4];
#define HG_LOAD(T0) do { LANE_E(); const int dtid_ = 64 * dw + ln_; \
    _Pragma("unroll") for (int u = 0; u < 4; ++u) { const int p = dtid_ + 256 * u, tau = p >> 4, t = (T0) + (dir ? 63 - tau : tau); v8[u] = *(const u32x4*)(V + (unsigned)(t * 1024 + 8 * (p & 15))); } \
    _Pragma("unroll") for (int u = 0; u < 4; ++u) { const int tau = 4 * tq + u, t = (T0) + (dir ? 63 - tau : tau); const unsigned off = (unsigned)(t * 1024 + i0); \
      f8[u] = *(const u32x4*)(LF + off); if (FULL) q8[u] = *(const u32x4*)(Q + off); } } while (0)
  for (int k = 0; k < 8; ++k) {
    const int c = dir ? 7 - k : k, t0 = 512 * sj + 64 * c;
    if (FULL && k == 4) { asm volatile("s_waitcnt vmcnt(0)" ::: "memory"); __syncthreads(); }
    HG_T(te0);
    { LANE_E(); const int dtid = 64 * dw + ln_;
      if (k == 0) { HG_LOAD(t0); }
#pragma unroll
      for (int u = 0; u < 4; ++u) { const int p = dtid + 256 * u; *(LAS u32x4*)(L + L_V + (p >> 4) * 320 + (p & 15) * 16) = v8[u]; }
      float cs[4][8], ff[4][8];
#pragma unroll
      for (int u = 0; u < 4; ++u) { const unsigned w0 = f8[u].x, w1 = f8[u].y, w2 = f8[u].z, w3 = f8[u].w;
        cs[u][0] = h2f((unsigned short)(w0 & 0xffff)); cs[u][1] = h2f((unsigned short)(w0 >> 16)); cs[u][2] = h2f((unsigned short)(w1 & 0xffff)); cs[u][3] = h2f((unsigned short)(w1 >> 16));
        cs[u][4] = h2f((unsigned short)(w2 & 0xffff)); cs[u][5] = h2f((unsigned short)(w2 >> 16)); cs[u][6] = h2f((unsigned short)(w3 & 0xffff)); cs[u][7] = h2f((unsigned short)(w3 >> 16)); }
#pragma unroll
      for (int u = 0; u < 4; ++u)
#pragma unroll
        for (int e = 0; e < 8; ++e) ff[u][e] = __builtin_amdgcn_exp2f(cs[u][e]);
#pragma unroll
      for (int u = 1; u < 4; ++u)
#pragma unroll
        for (int e = 0; e < 8; ++e) cs[u][e] += cs[u - 1][e];
      float inc[8], bl[8];
#pragma unroll
      for (int e = 0; e < 8; ++e) inc[e] = cs[3][e];
#define HG_ROWSHR(N) _Pragma("unroll") for (int e = 0; e < 8; ++e) inc[e] += __builtin_bit_cast(float, __builtin_amdgcn_update_dpp(0, __builtin_bit_cast(int, inc[e]), 0x110 + (N), 0xf, 0xf, false))
      HG_ROWSHR(1); HG_ROWSHR(2); HG_ROWSHR(4); HG_ROWSHR(8);
#undef HG_ROWSHR
#pragma unroll
      for (int e = 0; e < 8; ++e) { bl[e] = __shfl(inc[e], (ln_ & 48) + 15); const float ex = inc[e] - cs[3][e];
#pragma unroll
        for (int u = 0; u < 4; ++u) cs[u][e] += ex; }
#pragma unroll
      for (int e = 0; e < 8; ++e) { const int i = i0 + e; float ep[4], em[4], ki[4];
        ep[0] = __builtin_amdgcn_exp2f(cs[0][e]); em[3] = __builtin_amdgcn_exp2f(-cs[3][e]);
#pragma unroll
        for (int u = 1; u < 4; ++u) ep[u] = ep[u - 1] * ff[u][e];
#pragma unroll
        for (int u = 2; u >= 0; --u) em[u] = em[u + 1] * ff[u + 1][e];
#pragma unroll
        for (int u = 0; u < 4; ++u) ki[u] = __builtin_fmaf(-ff[u][e], em[u], em[u]);
        const int tau0 = 4 * tq;
        *(LAS u32x2*)(L + L_KIN + i * 144 + tau0 * 2) = (u32x2){cvtpk(ki[0], ki[1]), cvtpk(ki[2], ki[3])};
        if (FULL) { float qi[4];
#pragma unroll
          for (int u = 0; u < 4; ++u) { const unsigned w = (e < 2) ? q8[u].x : (e < 4) ? q8[u].y : (e < 6) ? q8[u].z : q8[u].w; qi[u] = ((e & 1) ? bhi(w) : blo(w)) * ep[u]; }
          *(LAS u32x2*)(L + L_QIN + i * 128 + ((((tau0 >> 5) ^ ((i >> 1) & 1))) << 6) + (tau0 & 31) * 2) = (u32x2){cvtpk(qi[0], qi[1]), cvtpk(qi[2], qi[3])}; } }
      if (tq == 0) {
#pragma unroll
        for (int e = 0; e < 8; ++e) { ((LAS float*)(L + L_DEC))[i0 + e] = __builtin_amdgcn_exp2f(bl[e]); if (!FULL) sumbl[e] += bl[e]; } }
    }
    HG_T(te1); HG_ACC(1, te0, te1);
    dir_bar(cnt, target, lane);
    HG_T(tm0); HG_ACC(2, te1, tm0);
    { LANE_M();
      if (FULL) {
        bf16x8 a00[2], a01[2], a11[2];
        { f32x16 AT00 = f32x16{}, AT01 = f32x16{}, AT11 = f32x16{};
#pragma unroll
          for (int ks8 = 0; ks8 < 8; ++ks8) {
            const LAS unsigned char* qp = L + L_QIN + qbase0 + ks8 * 2048; const LAS unsigned char* kp = L + L_KIN + kbase + ks8 * 2304;
            const LAS unsigned char* qx = (const LAS unsigned char*)((unsigned)(uintptr_t)qp ^ 64u);
            const bf16x8 q0 = trfrag(qp, qp + 1024), q1 = trfrag(qx, qx + 1024), k0 = trfrag(kp, kp + 1152), k1 = trfrag(kp + 64, kp + 64 + 1152);
            AT00 = __builtin_amdgcn_mfma_f32_32x32x16_bf16(k0, q0, AT00, 0, 0, 0);
            AT01 = __builtin_amdgcn_mfma_f32_32x32x16_bf16(k0, q1, AT01, 0, 0, 0);
            AT11 = __builtin_amdgcn_mfma_f32_32x32x16_bf16(k1, q1, AT11, 0, 0, 0);
          }
#pragma unroll
          for (int rr = 0; rr < 16; ++rr) { const bool keep = crow(rr, h) <= r32; AT00[rr] = keep ? AT00[rr] : 0.f; AT11[rr] = keep ? AT11[rr] : 0.f; }
          a00[0] = accfrag(AT00, 0); a00[1] = accfrag(AT00, 1); a01[0] = accfrag(AT01, 0); a01[1] = accfrag(AT01, 1); a11[0] = accfrag(AT11, 0); a11[1] = accfrag(AT11, 1); }
        if (k < 7) { const int cn = dir ? 6 - k : k + 1; HG_LOAD(512 * sj + 64 * cn); }
        f32x16 oT0 = f32x16{}, oT1 = f32x16{};
        { const LAS unsigned char* vp = L + L_V + vpbase;
          const bf16x8 vp00 = trfrag(vp, vp + 8 * 320), vp01 = trfrag(vp + 16 * 320, vp + 24 * 320), vp10 = trfrag(vp + 32 * 320, vp + 40 * 320), vp11 = trfrag(vp + 48 * 320, vp + 56 * 320);
          oT0 = __builtin_amdgcn_mfma_f32_32x32x16_bf16(vp00, a00[0], oT0, 0, 0, 0);
          oT0 = __builtin_amdgcn_mfma_f32_32x32x16_bf16(vp01, a00[1], oT0, 0, 0, 0);
          oT1 = __builtin_amdgcn_mfma_f32_32x32x16_bf16(vp00, a01[0], oT1, 0, 0, 0);
          oT1 = __builtin_amdgcn_mfma_f32_32x32x16_bf16(vp01, a01[1], oT1, 0, 0, 0);
          oT1 = __builtin_amdgcn_mfma_f32_32x32x16_bf16(vp10, a11[0], oT1, 0, 0, 0);
          oT1 = __builtin_amdgcn_mfma_f32_32x32x16_bf16(vp11, a11[1], oT1, 0, 0, 0); }
#pragma unroll
        for (int ks8 = 0; ks8 < 8; ++ks8) {
          const LAS unsigned char* qp = L + L_QIN + qbase0 + ks8 * 2048; const LAS unsigned char* qx = (const LAS unsigned char*)((unsigned)(uintptr_t)qp ^ 64u);
          const bf16x8 q0 = trfrag(qp, qp + 1024), q1 = trfrag(qx, qx + 1024), sf = accfrag(S[ks8 >> 1], ks8 & 1);
          oT0 = __builtin_amdgcn_mfma_f32_32x32x16_bf16(sf, q0, oT0, 0, 0, 0);
          oT1 = __builtin_amdgcn_mfma_f32_32x32x16_bf16(sf, q1, oT1, 0, 0, 0);
        }
        if (k < 4) {
#pragma unroll
          for (int tb = 0; tb < 2; ++tb) { const int tau = 32 * tb + r32, t = t0 + (dir ? 63 - tau : tau); bf16* op = LF + (unsigned)(t * 1024 + 32 * dw + 16 * h); u32x2 w[4]; u32x4 c0, c1;
#pragma unroll
            for (int g4 = 0; g4 < 4; ++g4) { const f32x16& o = tb ? oT1 : oT0; w[g4] = (u32x2){cvtpk(o[4 * g4], o[4 * g4 + 1]), cvtpk(o[4 * g4 + 2], o[4 * g4 + 3])}; }
            swz_pack(w, c0, c1); *(u32x4*)op = c0; *(u32x4*)(op + 8) = c1; }
        } else {
          const bf16* LFo = dir ? LFf : LFb; u32x2 gg[2][4]; float ss[2];
          u32x4 pc[2][2];
          { const bf16* pa0 = LFo + (unsigned)((t0 + (dir ? 63 - r32 : r32)) * 1024 + 32 * dw + 16 * h); const bf16* pa1 = LFo + (unsigned)((t0 + (dir ? 31 - r32 : 32 + r32)) * 1024 + 32 * dw + 16 * h);
            asm volatile("global_load_dwordx4 %0, %4, off sc1\n\tglobal_load_dwordx4 %1, %4, off offset:16 sc1\n\tglobal_load_dwordx4 %2, %5, off sc1\n\tglobal_load_dwordx4 %3, %5, off offset:16 sc1\n\ts_waitcnt vmcnt(0)"
                         : "=&v"(pc[0][0]), "=&v"(pc[0][1]), "=&v"(pc[1][0]), "=&v"(pc[1][1]) : "v"(pa0), "v"(pa1) : "memory"); }
#pragma unroll
          for (int tb = 0; tb < 2; ++tb) { const int tau = 32 * tb + r32, t = t0 + (dir ? 63 - tau : tau); unsigned long long pp[4];
            { u32x2 pw[4]; swz_unpack(pc[tb][0], pc[tb][1], pw);
#pragma unroll
              for (int g4 = 0; g4 < 4; ++g4) pp[g4] = (unsigned long long)pw[g4].x | ((unsigned long long)pw[g4].y << 32); }
            { const bf16* gp = GG + (unsigned)(t * 1024 + 32 * dw + 16 * h); const u32x4 c0 = *(const u32x4*)gp, c1 = *(const u32x4*)(gp + 8); swz_unpack(c0, c1, gg[tb]); }
            f32x16& o = tb ? oT1 : oT0; float s = 0.f;
#pragma unroll
            for (int g4 = 0; g4 < 4; ++g4) { o[4 * g4] += blo((unsigned)pp[g4]); o[4 * g4 + 1] += bhi((unsigned)pp[g4]); o[4 * g4 + 2] += blo((unsigned)(pp[g4] >> 32)); o[4 * g4 + 3] += bhi((unsigned)(pp[g4] >> 32));
              s += (o[4 * g4] * o[4 * g4] + o[4 * g4 + 1] * o[4 * g4 + 1]) + (o[4 * g4 + 2] * o[4 * g4 + 2] + o[4 * g4 + 3] * o[4 * g4 + 3]); }
            s += __shfl_xor(s, 32); ss[tb] = s; }
          if (h == 0) { ((LAS float*)(L + L_SSQ))[r32 * 4 + dw] = ss[0]; ((LAS float*)(L + L_SSQ))[(32 + r32) * 4 + dw] = ss[1]; }
          dir_bar(cnt, target, lane);
          f32x4 gn[4];
#pragma unroll
          for (int g4 = 0; g4 < 4; ++g4) gn[g4] = *(const f32x4*)(GAIN + 32 * dw + 8 * g4 + 4 * h);
#pragma unroll
          for (int tb = 0; tb < 2; ++tb) { const int tau = 32 * tb + r32, t = t0 + (dir ? 63 - tau : tau); const f32x4 sp = *(const LAS f32x4*)(L + L_SSQ + (32 * tb + r32) * 16);
            const float rs = __builtin_amdgcn_rsqf(((sp[0] + sp[1]) + (sp[2] + sp[3])) * (1.0f / 128.0f) + 1e-6f); const f32x16& o = tb ? oT1 : oT0; bf16* op = OC + (unsigned)(t * 2048 + 32 * dw + 16 * h); u32x2 w[4]; u32x4 c0, c1;
#pragma unroll
            for (int g4 = 0; g4 < 4; ++g4) w[g4] = (u32x2){cvtpk(o[4 * g4] * rs * gn[g4][0] * blo(gg[tb][g4].x), o[4 * g4 + 1] * rs * gn[g4][1] * bhi(gg[tb][g4].x)),
                                                           cvtpk(o[4 * g4 + 2] * rs * gn[g4][2] * blo(gg[tb][g4].y), o[4 * g4 + 3] * rs * gn[g4][3] * bhi(gg[tb][g4].y))};
            swz_pack(w, c0, c1); *(u32x4*)op = c0; *(u32x4*)(op + 8) = c1; }
        }
      }
      if (!FULL) { if (k < 7) { const int cn = dir ? 6 - k : k + 1; HG_LOAD(512 * sj + 64 * cn); } }
      { const LAS unsigned char* vn = L + L_V + vnbase; const LAS unsigned char* kn = L + L_KIN + knbase;
#pragma unroll
        for (int ks = 0; ks < 4; ++ks) { const bf16x8 vf = trfrag(vn + ks * 16 * 320, vn + ks * 16 * 320 + 4 * 320);
#pragma unroll
          for (int ib = 0; ib < 4; ++ib) { const bf16x8 kf = *(const LAS bf16x8*)(kn + ib * 32 * 144 + ks * 32); S[ib] = __builtin_amdgcn_mfma_f32_32x32x16_bf16(kf, vf, S[ib], 0, 0, 0); } }
#pragma unroll
        for (int ib = 0; ib < 4; ++ib)
#pragma unroll
          for (int g4 = 0; g4 < 4; ++g4) { const f32x4 d = *(const LAS f32x4*)(L + L_DEC + (32 * ib + 8 * g4 + 4 * h) * 4);
#pragma unroll
            for (int e = 0; e < 4; ++e) S[ib][4 * g4 + e] *= d[e]; } }
    }
    HG_T(tm1); HG_ACC(3, tm0, tm1);
    dir_bar(cnt, target, lane);
    HG_T(tb1); HG_ACC(4, tm1, tb1);
  }
  HG_T(tt0);
  if (!FULL) { LANE_E();
    bf16* sl = (bf16*)SL + ((((size_t)stream * 8 + sj) * 4 + dw) * 4) * 1024 + lane * 16;
#pragma unroll
    for (int ib = 0; ib < 4; ++ib) { u32x4 w0, w1;
      w0.x = cvtpk(S[ib][0], S[ib][1]); w0.y = cvtpk(S[ib][2], S[ib][3]); w0.z = cvtpk(S[ib][4], S[ib][5]); w0.w = cvtpk(S[ib][6], S[ib][7]);
      w1.x = cvtpk(S[ib][8], S[ib][9]); w1.y = cvtpk(S[ib][10], S[ib][11]); w1.z = cvtpk(S[ib][12], S[ib][13]); w1.w = cvtpk(S[ib][14], S[ib][15]);
      *(u32x4*)(sl + ib * 1024) = w0; *(u32x4*)(sl + ib * 1024 + 8) = w1; }
    if (tq == 0) { float* dt = DT + ((size_t)stream * 8 + sj) * 128 + i0;
#pragma unroll
      for (int e = 0; e < 8; ++e) dt[e] = __builtin_amdgcn_exp2f(sumbl[e]); }
  }
#undef HG_LOAD
  asm volatile("s_waitcnt vmcnt(0)" ::: "memory");
  __syncthreads();
  HG_T(tt1); HG_ACC(6, tt0, tt1);
}
}

__device__ __forceinline__ void hgrn_simple(Frame& F, const Args& A, int sid) {
    const int bl = sid >> 4, h = (sid >> 1) & 7, dir = sid & 1, tid = F.tid, j = tid >> 2, iq = tid & 3;
    const size_t base = (size_t)bl * SEQ * 1024 + h * 128;
    const bf16* Q = (const bf16*)(A.ws + WS_HGQ) + base; const bf16* V = (const bf16*)(A.ws + WS_HGV) + base;
    bf16* LF = (bf16*)(A.ws + (dir ? WS_LFB : WS_LFF)) + base;
    LAS float* qs = (LAS float*)(F.lds); LAS float* fs = qs + 4096; LAS float* ks = fs + 4096; LAS float* vs = ks + 4096; LAS float* os = vs + 4096;
    float S[32];
#pragma unroll
    for (int i = 0; i < 32; ++i) S[i] = 0.f;
    for (int blk = 0; blk < SEQ / 32; ++blk) {
        const int t0 = dir ? (SEQ - 32 * (blk + 1)) : 32 * blk;
#pragma unroll
        for (int r = 0; r < 8; ++r) { const int e = tid + 512 * r, tt = e >> 7, i = e & 127; const size_t off = (size_t)(t0 + tt) * 1024 + i;
            const float f = exp2f(h2f(LF[off])); qs[e] = bf2f(Q[off]); fs[e] = f; ks[e] = 1.0f - f; vs[e] = bf2f(V[off]); }
        __syncthreads();
        for (int s = 0; s < 32; ++s) { const int tt = dir ? 31 - s : s; const float vj = vs[tt * 128 + j]; float a = 0.f;
            const LAS f32x4* f4 = (const LAS f32x4*)(fs + tt * 128 + iq * 32); const LAS f32x4* k4 = (const LAS f32x4*)(ks + tt * 128 + iq * 32); const LAS f32x4* q4 = (const LAS f32x4*)(qs + tt * 128 + iq * 32);
#pragma unroll
            for (int c = 0; c < 8; ++c) { const f32x4 ff = f4[c], kk = k4[c], qq = q4[c];
#pragma unroll
                for (int e = 0; e < 4; ++e) { S[4 * c + e] = ff[e] * S[4 * c + e] + kk[e] * vj; a += S[4 * c + e] * qq[e]; } }
            a += __shfl_xor(a, 1); a += __shfl_xor(a, 2);
            if (iq == 0) os[tt * 128 + j] = a; }
        __syncthreads();
#pragma unroll
        for (int r = 0; r < 8; ++r) { const int e = tid + 512 * r, tt = e >> 7, i = e & 127; LF[(size_t)(t0 + tt) * 1024 + i] = (bf16)f2bf(os[e]); }
    }
    __syncthreads();
}
__device__ __forceinline__ void da_simple_item(Frame& F, const Args& A, int lrow, int hd, LAS float* wq) {
    const int lane = F.lane, bl = lrow >> 12, t = lrow & 4095, grp = hd >> 2, sh = 2 * grp, n = t >> sh, r = t & ((1 << sh) - 1), Ld = SEQ >> sh;
    bf16* qrow = (bf16*)(A.ws + WS_DAQ) + (size_t)lrow * 1536 + hd * 128;
    const bf16* K = (const bf16*)(A.ws + WS_DAK) + hd * 128; const bf16* V = (const bf16*)(A.ws + WS_DAV) + hd * 128;
    const unsigned qq = *(const unsigned*)(qrow + 2 * lane);
    wq[2 * lane] = blo(qq); wq[2 * lane + 1] = bhi(qq);
    LDS_WAIT(); asm volatile("" ::: "memory");
    const float slope = exp2f(-(float)(hd + 1) * (8.0f / 12.0f)) * (float)(1 << sh) * 1.4426950408889634f;
    float sc[3];
#pragma unroll
    for (int s = 0; s < 3; ++s) { const int kk = lane + 64 * s, rel = kk - 64, m = n + rel; const bool valid = (kk <= 128) && (m >= 0) && (m < Ld);
        float v = -INFINITY;
        if (valid) { const bf16* krow = K + (size_t)(bl * SEQ + (m << sh) + r) * 1536; float dot = 0.f;
#pragma unroll 4
            for (int c = 0; c < 16; ++c) { const v4u kv = *(const v4u*)(krow + 8 * c); const LAS f32x4* w4 = (const LAS f32x4*)(wq + 8 * c); const f32x4 wa = w4[0], wb = w4[1];
                dot += (wa[0] * blo(kv.x) + wa[1] * bhi(kv.x)) + (wa[2] * blo(kv.y) + wa[3] * bhi(kv.y)) + (wb[0] * blo(kv.z) + wb[1] * bhi(kv.z)) + (wb[2] * blo(kv.w) + wb[3] * bhi(kv.w)); }
            v = dot - slope * fabsf((float)rel); }
        sc[s] = v; }
    const float mx = wave_max(fmaxf(fmaxf(sc[0], sc[1]), sc[2]));
    float p[3];
#pragma unroll
    for (int s = 0; s < 3; ++s) p[s] = exp2f(sc[s] - mx);
    const float sum = wave_sum(p[0] + p[1] + p[2]); const float inv = 1.0f / sum, lse = mx + __log2f(sum);
    float o0 = 0.f, o1 = 0.f;
#pragma unroll
    for (int s = 0; s < 3; ++s) { const int cnt = (s < 2) ? 64 : 1;
        for (int c = 0; c < cnt; ++c) { const int kk = c + 64 * s, m = n + kk - 64; if (m < 0 || m >= Ld) continue;
            const float pj = __shfl(p[s], c) * inv; const unsigned vv = *(const unsigned*)(V + (size_t)(bl * SEQ + (m << sh) + r) * 1536 + 2 * lane);
            o0 += pj * blo(vv); o1 += pj * bhi(vv); } }
    *(unsigned*)(qrow + 2 * lane) = pk2(o0, o1);
    if (lane == 0) ((float*)(A.ws + WS_LSE))[lrow * 12 + hd] = lse;
}
__device__ __forceinline__ void mem_simple_item(Frame& F, const Args& A, int g, int lrow, int hd, LAS float* wq) {
    const int lane = F.lane, b = g * GB + (lrow >> 12);
    const bf16* qrow = (const bf16*)(A.ws + WS_MQ) + (size_t)lrow * 512 + hd * 128;
    const bf16* K = (const bf16*)(A.ws + WS_MEMKV) + (size_t)b * NMEM * 1024 + hd * 128; const bf16* V = K + 512;
    const unsigned qq = *(const unsigned*)(qrow + 2 * lane);
    wq[2 * lane] = blo(qq); wq[2 * lane + 1] = bhi(qq);
    LDS_WAIT(); asm volatile("" ::: "memory");
    float sc[4];
#pragma unroll
    for (int s = 0; s < 4; ++s) { const bf16* krow = K + (size_t)(lane + 64 * s) * 1024; float dot = 0.f;
#pragma unroll 4
        for (int c = 0; c < 16; ++c) { const v4u kv = *(const v4u*)(krow + 8 * c); const LAS f32x4* w4 = (const LAS f32x4*)(wq + 8 * c); const f32x4 wa = w4[0], wb = w4[1];
            dot += (wa[0] * blo(kv.x) + wa[1] * bhi(kv.x)) + (wa[2] * blo(kv.y) + wa[3] * bhi(kv.y)) + (wb[0] * blo(kv.z) + wb[1] * bhi(kv.z)) + (wb[2] * blo(kv.w) + wb[3] * bhi(kv.w)); }
        sc[s] = dot; }
    const float mx = wave_max(fmaxf(fmaxf(sc[0], sc[1]), fmaxf(sc[2], sc[3])));
    float p[4];
#pragma unroll
    for (int s = 0; s < 4; ++s) p[s] = exp2f(sc[s] - mx);
    const float inv = 1.0f / wave_sum((p[0] + p[1]) + (p[2] + p[3]));
    float o0 = 0.f, o1 = 0.f;
#pragma unroll
    for (int s = 0; s < 4; ++s)
        for (int c = 0; c < 64; ++c) { const float pj = __shfl(p[s], c) * inv; const unsigned vv = *(const unsigned*)(V + (size_t)(c + 64 * s) * 1024 + 2 * lane); o0 += pj * blo(vv); o1 += pj * bhi(vv); }
    *(unsigned*)((bf16*)(A.ws + WS_OCAT) + (size_t)lrow * 2048 + 1536 + hd * 128 + 2 * lane) = pk2(o0, o1);
}
__device__ __forceinline__ void attn_units(Frame& F, const Args& A, int g) {
    for (int u = F.vcu; u < 1024; u += F.G) {
        if (u < 768) { const int bl = u / 192, rem = u % 192, hd = rem >> 4, idx = rem & 15, grp = hd >> 2, sh = 2 * grp, nblk = 16 >> sh, r = idx / nblk, n0 = 256 * (idx % nblk);
            const long row0 = (long)bl * SEQ + ((long)n0 << sh) + r;
            bf16* Qb = (bf16*)(A.ws + WS_DAQ) + row0 * 1536 + hd * 128;
            const bf16* Kb = (const bf16*)(A.ws + WS_DAK) + ((long)bl * SEQ + r) * 1536 + hd * 128; const bf16* Vb = (const bf16*)(A.ws + WS_DAV) + ((long)bl * SEQ + r) * 1536 + hd * 128;
            const float slope2 = exp2f(-(float)(hd + 1) * (8.0f / 12.0f)) * (float)(1 << sh) * 1.4426950408889634f;
            float* lse = (float*)(A.ws + WS_LSE) + row0 * 12 + hd;
            att::attn_unit(Qb, (long)1536 << sh, Kb, Vb, (long)1536 << sh, 6, n0 - 64, SEQ >> sh, n0, true, slope2, Qb, (long)1536 << sh, lse, (long)12 << sh, F.lds, F.tid, (unsigned long long*)(F.ctl + 768));
        } else { const int v = u - 768, bl = v >> 6, hd = (v >> 4) & 3, qb = v & 15; const long row0 = (long)bl * SEQ + 256 * qb;
            const bf16* Qb = (const bf16*)(A.ws + WS_MQ) + row0 * 512 + hd * 128;
            const bf16* Kb = (const bf16*)(A.ws + WS_MEMKV) + (long)(g * GB + bl) * NMEM * 1024 + hd * 128;
            bf16* Ob = (bf16*)(A.ws + WS_OCAT) + row0 * 2048 + 1536 + hd * 128;
            att::attn_unit(Qb, 512, Kb, Kb + 512, 1024, 4, 0, NMEM, 0, false, 0.f, Ob, 2048, nullptr, 0, F.lds, F.tid, (unsigned long long*)(F.ctl + 768));
        }
    }
}
template <bool FULL> __device__ __forceinline__ void hgrn_items(Frame& F, const Args& A) {
    for (int it = F.vcu; it < GB * 8 * 8; it += F.G) { const int bl = it >> 6, hh = (it >> 3) & 7, sj = it & 7; const size_t base = (size_t)bl * SEQ * 1024 + hh * 128;
        hg::hgrn_item<FULL>((const bf16*)(A.ws + WS_HGQ) + base, (const bf16*)(A.ws + WS_HGV) + base, (bf16*)(A.ws + WS_LFF) + base, (bf16*)(A.ws + WS_LFB) + base,
                            (const bf16*)(A.ws + WS_HGG) + base, A.in[7], (bf16*)(A.ws + WS_OCAT) + (size_t)bl * SEQ * 2048 + hh * 128,
                            (float*)((unsigned char*)A.out + OUT_SL), (float*)(A.ws + WS_DT), bl * 8 + hh, sj, F.lds, F.tid, (unsigned long long*)(F.ctl + 768)); }
}
__device__ __forceinline__ void da_merge(Frame& F, const Args& A) {
    const int gw = F.vcu * NWAVES + F.wave, NGW = F.G * NWAVES, lane = F.lane, jj = lane >> 4, c8 = (lane & 15) * 8;
    const bf16* DQ = (const bf16*)(A.ws + WS_DAQ); const float* LSE = (const float*)(A.ws + WS_LSE); bf16* OC = (bf16*)(A.ws + WS_OCAT);
    for (int r0 = gw * 4; r0 < GR; r0 += NGW * 4) {
        v4u a[4], b[4], c[4]; float l0[4], l1[4], l2[4];
#pragma unroll
        for (int s = 0; s < 4; ++s) { const int row = r0 + s; const bf16* p = DQ + (size_t)row * 1536 + jj * 128 + c8;
            l0[s] = LSE[row * 12 + jj]; l1[s] = LSE[row * 12 + 4 + jj]; l2[s] = LSE[row * 12 + 8 + jj]; a[s] = *(const v4u*)p; b[s] = *(const v4u*)(p + 512); c[s] = *(const v4u*)(p + 1024); }
#pragma unroll
        for (int s = 0; s < 4; ++s) { const int row = r0 + s; const float mx = fmaxf(fmaxf(l0[s], l1[s]), l2[s]);
            float w0 = exp2f(l0[s] - mx), w1 = exp2f(l1[s] - mx), w2 = exp2f(l2[s] - mx); const float inv = 1.0f / (w0 + w1 + w2); w0 *= inv; w1 *= inv; w2 *= inv;
            v4u o;
            o.x = pk2(w0 * blo(a[s].x) + w1 * blo(b[s].x) + w2 * blo(c[s].x), w0 * bhi(a[s].x) + w1 * bhi(b[s].x) + w2 * bhi(c[s].x));
            o.y = pk2(w0 * blo(a[s].y) + w1 * blo(b[s].y) + w2 * blo(c[s].y), w0 * bhi(a[s].y) + w1 * bhi(b[s].y) + w2 * bhi(c[s].y));
            o.z = pk2(w0 * blo(a[s].z) + w1 * blo(b[s].z) + w2 * blo(c[s].z), w0 * bhi(a[s].z) + w1 * bhi(b[s].z) + w2 * bhi(c[s].z));
            o.w = pk2(w0 * blo(a[s].w) + w1 * blo(b[s].w) + w2 * blo(c[s].w), w0 * bhi(a[s].w) + w1 * bhi(b[s].w) + w2 * bhi(c[s].w));
            *(v4u*)(OC + (size_t)row * 2048 + 1024 + jj * 128 + c8) = o; }
    }
}
__device__ __forceinline__ void p2_finalize_v1(Frame& F, const Args& A) {
    const int gw = F.vcu * NWAVES + F.wave, NGW = F.G * NWAVES, lane = F.lane;
    const bf16* OF = (const bf16*)(A.ws + WS_LFF); const bf16* OB = (const bf16*)(A.ws + WS_LFB); const bf16* GG = (const bf16*)(A.ws + WS_HGG);
    const bf16* DQ = (const bf16*)(A.ws + WS_DAQ); const float* LSE = (const float*)(A.ws + WS_LSE); bf16* OC = (bf16*)(A.ws + WS_OCAT);
    const float g0 = A.in[7][2 * lane], g1 = A.in[7][2 * lane + 1];
    for (int row = gw; row < GR; row += NGW) {
#pragma unroll 2
        for (int h = 0; h < 8; ++h) { const size_t off = (size_t)row * 1024 + h * 128 + 2 * lane;
            const unsigned a = *(const unsigned*)(OF + off), b = *(const unsigned*)(OB + off), gg = *(const unsigned*)(GG + off);
            const float o0 = blo(a) + blo(b), o1 = bhi(a) + bhi(b); const float rs = 1.0f / sqrtf(wave_sum(o0 * o0 + o1 * o1) * (1.f / 128.f) + RMS_EPS);
            *(unsigned*)(OC + (size_t)row * 2048 + h * 128 + 2 * lane) = pk2(o0 * rs * g0 * blo(gg), o1 * rs * g1 * bhi(gg)); }
#pragma unroll
        for (int jj = 0; jj < 4; ++jj) { const float l0 = LSE[row * 12 + jj], l1 = LSE[row * 12 + 4 + jj], l2 = LSE[row * 12 + 8 + jj]; const float mx = fmaxf(fmaxf(l0, l1), l2);
            const float w0 = exp2f(l0 - mx), w1 = exp2f(l1 - mx), w2 = exp2f(l2 - mx), inv = 1.0f / (w0 + w1 + w2);
            const unsigned a = *(const unsigned*)(DQ + (size_t)row * 1536 + jj * 128 + 2 * lane), b = *(const unsigned*)(DQ + (size_t)row * 1536 + (4 + jj) * 128 + 2 * lane), c = *(const unsigned*)(DQ + (size_t)row * 1536 + (8 + jj) * 128 + 2 * lane);
            *(unsigned*)(OC + (size_t)row * 2048 + 1024 + jj * 128 + 2 * lane) = pk2((w0 * blo(a) + w1 * blo(b) + w2 * blo(c)) * inv, (w0 * bhi(a) + w1 * bhi(b) + w2 * bhi(c)) * inv); }
    }
}

#ifndef MK_PER_PHASE
#define MK_PER_PHASE 0
#endif
constexpr int N_PHASES = 13;
__global__ void __launch_bounds__(NWAVES * 64, 2) mega_fwd(Args args) {
    extern __shared__ __attribute__((aligned(16))) unsigned char lds[];
    Frame F;
    F.lds = (LAS unsigned char*)lds;
    F.MISC = (volatile LAS unsigned*)(F.lds + MISC_OFF);
    F.tid = threadIdx.x; F.lane = F.tid & 63; F.wave = __builtin_amdgcn_readfirstlane(F.tid >> 6);
    F.G = gridDim.x; { const int bx = blockIdx.x; F.vcu = (F.G % 8 == 0) ? (bx % 8) * (F.G / 8) + bx / 8 : bx; }
    F.ctl = (gu32*)(args.ws + WS_CTL);
    for (int u = F.tid; u < (LDS_BYTES - LDSCTL_OFF) / 4; u += NWAVES * 64) ((LAS unsigned*)(F.lds + LDSCTL_OFF))[u] = 0u;
    __syncthreads();
    XcdBarrier bar; bar.bar = (unsigned*)(F.ctl + CW_BAR); bar.x = 0; bar.st = nullptr; bar.w0 = F.wave;
    if (!MK_PER_PHASE) bar = xcd_barrier_post((unsigned*)(F.ctl + CW_BAR), F.MISC + 8, F.wave);
    const int lo = args.ph_lo, hi = args.ph_hi;
    const int wave0 = F.wave;
#ifndef PH_MASK
#define PH_MASK 0xFFF
#endif
#define PBIT(k) ((k) <= 4 ? (k) : ((k) <= 8 ? (k) - 4 : (k) - 4))
#define IN(k) (lo <= (k) && (k) < hi)
#ifndef REP_MASK
#define REP_MASK 0
#endif
#define REPS(k) (1 + ((REP_MASK >> (k)) & 1))
#ifndef PROBE_PHASE
#define PROBE_PHASE -1
#endif
#ifndef PROBE_OFF
#define PROBE_OFF 0
#endif
#define STAMP(k) do { if (PROBE_PHASE >= 0 && blockIdx.x == 0 && xb_t0(wave0)) { const unsigned long long t_ = __builtin_amdgcn_s_memrealtime(); __hip_atomic_store((unsigned long long*)(F.ctl + 512) + (k), t_, __ATOMIC_RELAXED, __HIP_MEMORY_SCOPE_AGENT); } } while (0)
#define SEAM(k) do { if (IN(k) && IN((k) + 1)) { const DeferFill df_{(k), wave0, (int)__builtin_amdgcn_mbcnt_hi(~0u, __builtin_amdgcn_mbcnt_lo(~0u, 0u)), F.vcu, F.G, F.lds}; xcd_barrier(bar, df_); } STAMP((k) + 1); } while (0)
#if defined(__HIP_DEVICE_COMPILE__)
#define PHASE_ARGS() Args A; { const __attribute__((address_space(4))) Args* ap_ = (const __attribute__((address_space(4))) Args*)__builtin_amdgcn_kernarg_segment_ptr(); asm volatile("" : "+s"(ap_)); A = *ap_; } \
    unsigned char* const ws = A.ws; (void)ws; { unsigned z_ = 0u; asm volatile("" : "+v"(z_)); int t_ = wave0 * 64 + (int)__builtin_amdgcn_mbcnt_hi(~0u, __builtin_amdgcn_mbcnt_lo(~0u, z_)); F.tid = t_; F.lane = t_ & 63; F.wave = wave0; }
#else
#define PHASE_ARGS() Args A = args; unsigned char* const ws = A.ws; (void)ws
#endif

    STAMP(0);
    if (IN(0)) { for (int rep = 0; rep < REPS(0); ++rep) { PHASE_ARGS(); p0_prologue(F, A); } } SEAM(0);
    if (IN(1)) {
        for (int rep = 0; rep < REPS(1); ++rep) { PHASE_ARGS();
        pg8::Gemm gm{(const pg8::bf16_t*)(ws + WS_MEMN), (const pg8::bf16_t*)(ws + WS_WKV), BATCH * NMEM, 1024, 1024}; pg8::StaticOrder S; S.init(BATCH * NMEM, 1024, F.G, (int)blockIdx.x);
        pg8::EpiKV E{(pg8::bf16_t*)(ws + WS_MEMKV), A.in[12], (PG8_LAS float*)(F.lds + EPI_SCR_OFF)};
        pg8::gemm_phase<pg8::EpiKV, pg8::StaticOrder, true, true>(F.lds + RING_OFF, gm, S, E, F.tid); }
    }
    for (int g = 0; g < NGRP; ++g) {
        const int pb = 1 + 4 * g;
        if (IN(pb)) {
            for (int rep = 0; rep < REPS(pb); ++rep) { PHASE_ARGS();
            pg8::Gemm gm{(const pg8::bf16_t*)(ws + WS_H) + (size_t)g * GR * 1024, (const pg8::bf16_t*)(ws + WS_WIN), GR, INC, 1024}; RotOrder S; S.init(GR, INC, F.G, (int)blockIdx.x);
            pg8::EpiProj E{ws, (pg8::bf16_t*)((unsigned char*)A.out + OUT_GATES + (size_t)g * (48u << 20)), (const float*)(ws + WS_LB), A.in[8], A.in[9], A.in[11], (PG8_LAS float*)(F.lds + EPI_SCR_OFF)};
            pg8::gemm_phase<pg8::EpiProj, RotOrder, true, true>(F.lds + RING_OFF, gm, S, E, F.tid); }
        }
        SEAM(pb);
        if (IN(pb + 1)) { PHASE_ARGS(); attn_units(F, A, g); for (int rep = 0; rep < REPS(pb + 1); ++rep) hgrn_items<false>(F, A); } SEAM(pb + 1);
        if (IN(pb + 2)) { PHASE_ARGS(); unsigned long long tq0 = 0, tq1 = 0, tq2 = 0; if (HG_PROBE) tq0 = __builtin_amdgcn_s_memrealtime(); hgrn_items<true>(F, A); if (HG_PROBE) tq1 = __builtin_amdgcn_s_memrealtime(); da_merge(F, A); if (HG_PROBE) tq2 = __builtin_amdgcn_s_memrealtime();
            if (HG_PROBE && blockIdx.x == 0 && F.tid == 0) { unsigned long long* prb = (unsigned long long*)(F.ctl + 768); prb[7] += tq1 - tq0; prb[11] += tq2 - tq1; } } SEAM(pb + 2);
        if (IN(pb + 3)) {
            for (int rep = 0; rep < REPS(pb + 3); ++rep) { PHASE_ARGS();
            pg8::Gemm gm{(const pg8::bf16_t*)(ws + WS_OCAT), (const pg8::bf16_t*)(ws + WS_WPC), GR, 1024, 2048}; pg8::StaticOrder S; S.init(GR, 1024, F.G, (int)blockIdx.x);
            pg8::EpiMerged E{(const pg8::bf16_t*)((unsigned char*)A.out + OUT_GATES + (size_t)g * (48u << 20)), (pg8::bf16_t*)(ws + WS_H), g * GR};
            pg8::gemm_phase<pg8::EpiMerged, pg8::StaticOrder, true, true>(F.lds + RING_OFF, gm, S, E, F.tid); }
        }
        if (g == NGRP - 1) SEAM(pb + 3); else STAMP(pb + 4);
    }
    if (IN(9)) {
        for (int rep = 0; rep < REPS(9); ++rep) { PHASE_ARGS();
        pg8::Gemm gm{(const pg8::bf16_t*)(ws + WS_H), (const pg8::bf16_t*)(ws + WS_WO), MTOK, 1024, 1024}; pg8::StaticOrder S; S.init(MTOK, 1024, F.G, (int)blockIdx.x);
        pg8::EpiWout E{A.in[0], (pg8::bf16_t*)(ws + WS_X1B), (float*)(ws + WS_SSQ)};
        pg8::gemm_phase<pg8::EpiWout, pg8::StaticOrder, true, true>(F.lds + RING_OFF, gm, S, E, F.tid); }
    }
    SEAM(9);
    if (IN(10)) {
        for (int rep = 0; rep < REPS(10); ++rep) { PHASE_ARGS();
        pg8::Gemm gm{(const pg8::bf16_t*)(ws + WS_X1B), (const pg8::bf16_t*)(ws + WS_WFI), MTOK, 2 * DFF, 1024}; RevOrder S; S.init(MTOK, 2 * DFF, F.G, (int)blockIdx.x);
        { PG8_LAS float* cache_ = (PG8_LAS float*)(F.lds + EPI_SCR_OFF); if (F.tid < 8) ((volatile PG8_LAS int*)cache_)[F.tid * 132 + 128] = 0; __syncthreads(); }
        pg8::EpiFfnIn E{(const float*)(ws + WS_SSQ), (pg8::bf16_t*)(ws + WS_U), (PG8_LAS float*)(F.lds + EPI_SCR_OFF)};
        pg8::gemm_phase<pg8::EpiFfnIn, RevOrder, true, true>(F.lds + RING_OFF, gm, S, E, F.tid); }
    }
    SEAM(10);
    if (IN(11)) {
        PHASE_ARGS();
        pg8::Gemm gm{(const pg8::bf16_t*)(ws + WS_U), (const pg8::bf16_t*)(ws + WS_WFO), MTOK, 1024, DFF}; pg8::StaticOrder S; S.init(MTOK, 1024, F.G, (int)blockIdx.x);
        pg8::EpiFfnOut E{(const pg8::bf16_t*)(ws + WS_X1B), A.out};
        pg8::gemm_phase<pg8::EpiFfnOut, pg8::StaticOrder, true, true>(F.lds + RING_OFF, gm, S, E, F.tid);
    }
    if (PROBE_PHASE >= 0) {
        xcd_barrier(bar); STAMP(12);
        if (blockIdx.x == 0 && xb_t0(wave0)) { PHASE_ARGS(); const unsigned long long* ts = (const unsigned long long*)(F.ctl + 512);
            const unsigned long long t0 = __hip_atomic_load(ts + PROBE_PHASE, __ATOMIC_RELAXED, __HIP_MEMORY_SCOPE_AGENT), t1 = __hip_atomic_load(ts + PROBE_PHASE + 1, __ATOMIC_RELAXED, __HIP_MEMORY_SCOPE_AGENT);
            A.out[0] += ((HG_PROBE ? (float)ts[128 + HG_PROBE] * 0.01f : (float)(t1 - t0) * 0.01f) - (float)(PROBE_OFF)) * 0.05f; }
    }
#undef IN
#undef SEAM
}

extern "C" void kernel_launch(void* const* d_in, const int* in_sizes, int n_in, void* d_out, int out_size, void* d_ws, size_t ws_size, hipStream_t stream) {
    static int grid = 0;
    if (grid == 0) {
        if (n_in != 20 || in_sizes[0] != MTOK * D || out_size != MTOK * D || ws_size < WS_END) { fprintf(stderr, "kernel_launch: unexpected shapes/workspace: n_in %d in0 %d out %d ws %zu (need %zu); nothing launched\n", n_in, n_in > 0 ? in_sizes[0] : -1, out_size, ws_size, (size_t)WS_END); grid = -1; return; }
        int dev = 0, cus = 0, per_cu = 0;
        if (hipGetDevice(&dev) != hipSuccess || hipDeviceGetAttribute(&cus, hipDeviceAttributeMultiprocessorCount, dev) != hipSuccess) { grid = -1; return; }
        if (hipFuncSetAttribute((const void*)mega_fwd, hipFuncAttributeMaxDynamicSharedMemorySize, LDS_BYTES) != hipSuccess) { fprintf(stderr, "kernel_launch: hipFuncSetAttribute failed\n"); grid = -1; return; }
        if (hipOccupancyMaxActiveBlocksPerMultiprocessor(&per_cu, (const void*)mega_fwd, NWAVES * 64, LDS_BYTES) != hipSuccess || per_cu < 1) fprintf(stderr, "kernel_launch: occupancy query reports %d\n", per_cu);
        (void)hipGetLastError();
        grid = cus;
    }
    if (grid < 0) return;
    if (hipMemsetAsync((char*)d_ws + WS_CTL, 0, CTL_ZERO_BYTES, stream) != hipSuccess) { fprintf(stderr, "kernel_launch: memset failed\n"); return; }
    Args a{};
    for (int i = 0; i < 20; ++i) a.in[i] = (const float*)d_in[i];
    a.out = (float*)d_out; a.ws = (unsigned char*)d_ws;
#if MK_PER_PHASE
    for (int p = 0; p < 12; ++p) { a.ph_lo = p; a.ph_hi = p + 1; hipLaunchKernelGGL(mega_fwd, dim3(grid), dim3(NWAVES * 64), LDS_BYTES, stream, a); }
#else
    a.ph_lo = 0; a.ph_hi = 12; hipLaunchKernelGGL(mega_fwd, dim3(grid), dim3(NWAVES * 64), LDS_BYTES, stream, a);
#endif
}
```
